# Optimizing an MI355X kernel written in HIP

```python
import jax, jax.numpy as jnp
from jax import lax
import numpy as np

D_MODEL = 1024
BATCH = 2
SEQ = 16384
DEPTH = 4

CTX_LEN = 256
GRID_W = 64
N_MIXERS = 2
FFN_DIM = 2816
N_FOURIER_GROUPS = 4
FOURIER_GROUP_DIM = D_MODEL // N_FOURIER_GROUPS
RET_HEADS = 4
RET_QK_DIM = D_MODEL // RET_HEADS
RET_V_DIM = 2 * D_MODEL // RET_HEADS
RET_QK_TOTAL = RET_HEADS * RET_QK_DIM
RET_V_TOTAL = RET_HEADS * RET_V_DIM
RET_IN_DIM = 2 * RET_QK_TOTAL + 2 * RET_V_TOTAL
RET_CHUNK = 128
ROPE_BASE = 10000.0
N_MOD = 9
NORM_EPS = 1e-6
N_FOURIER_LAYERS = (DEPTH + N_MIXERS - 1) // N_MIXERS
N_RET_LAYERS = DEPTH // N_MIXERS

kernel_name = "hybrid_fourier_retention_prefix_dit"


def rmsnorm(x, g):
    xf = x.astype(jnp.float32)
    y = xf * lax.rsqrt(jnp.mean(xf * xf, axis=-1, keepdims=True) + NORM_EPS)
    return (y * g.astype(jnp.float32)).astype(x.dtype)


def modulate(h, shift, scale):
    return h * (1 + scale) + shift


def swiglu(h, w_gate, w_up, w_down):
    return (jax.nn.silu(h @ w_gate) * (h @ w_up)) @ w_down


def fourier_mix(h):
    b, n, d = h.shape
    hg = h.reshape(b, n, N_FOURIER_GROUPS, FOURIER_GROUP_DIM).astype(jnp.float32)
    f = jnp.fft.fft2(hg, axes=(1, 3), norm="ortho").real
    return f.reshape(b, n, d).astype(h.dtype)


def fourier_layer(h_lat, h_ctx, w, bias):
    y_lat = fourier_mix(h_lat) @ w + bias
    y_ctx = None if h_ctx is None else fourier_mix(h_ctx) @ w + bias
    return y_lat, y_ctx


def axial_rope(n_tokens):
    rows = n_tokens // GRID_W
    row = jnp.repeat(jnp.arange(rows, dtype=jnp.float32), GRID_W)
    col = jnp.tile(jnp.arange(GRID_W, dtype=jnp.float32), rows)
    n_freq = RET_QK_DIM // 4
    inv_freq = ROPE_BASE ** (-jnp.arange(n_freq, dtype=jnp.float32) / n_freq)
    ang = jnp.concatenate([row[:, None] * inv_freq, col[:, None] * inv_freq], axis=-1)
    return jnp.cos(ang), jnp.sin(ang)


def apply_rope(t, cos, sin):
    t1, t2 = jnp.split(t, 2, axis=-1)
    cos = cos.astype(t.dtype)
    sin = sin.astype(t.dtype)
    return jnp.concatenate([t1 * cos - t2 * sin, t2 * cos + t1 * sin], axis=-1)


def ret_project(h, w_in):
    b, n, _ = h.shape
    p = h @ w_in
    q, k, v, g = jnp.split(p, [RET_QK_TOTAL, 2 * RET_QK_TOTAL, 2 * RET_QK_TOTAL + RET_V_TOTAL], axis=-1)
    q = q.reshape(b, n, RET_HEADS, RET_QK_DIM).transpose(0, 2, 1, 3)
    k = k.reshape(b, n, RET_HEADS, RET_QK_DIM).transpose(0, 2, 1, 3) * (RET_QK_DIM ** -0.5)
    v = v.reshape(b, n, RET_HEADS, RET_V_DIM).transpose(0, 2, 1, 3)
    return q, k, v, g


def retention_scan(q, k, v, lg, s0):
    b, h, n, dk = q.shape
    dv = v.shape[-1]
    nc = n // RET_CHUNK
    dt = q.dtype
    pos = jnp.arange(RET_CHUNK, dtype=jnp.float32)
    diff = pos[:, None] - pos[None, :]
    intra = jnp.where(diff >= 0, jnp.exp(lg[:, None, None] * jnp.maximum(diff, 0.0)), 0.0).astype(dt)
    q_dec = jnp.exp(lg[:, None] * (pos + 1.0))[:, :, None].astype(dt)
    k_dec = jnp.exp(lg[:, None] * (RET_CHUNK - 1.0 - pos))[:, :, None].astype(dt)
    chunk_dec = jnp.exp(lg * RET_CHUNK)[:, None, None].astype(dt)

    def to_chunks(t):
        return jnp.moveaxis(t.reshape(b, h, nc, RET_CHUNK, t.shape[-1]), 2, 0)

    def step(s, qkv):
        qc, kc, vc = qkv
        scores = jnp.einsum('bhid,bhjd->bhij', qc, kc) * intra
        y = (jnp.einsum('bhij,bhje->bhie', scores, vc)
             + jnp.einsum('bhid,bhde->bhie', qc * q_dec, s))
        s = chunk_dec * s + jnp.einsum('bhjd,bhje->bhde', kc * k_dec, vc)
        return s, y

    s_final, y = lax.scan(step, s0, (to_chunks(q), to_chunks(k), to_chunks(v)))
    y = jnp.moveaxis(y, 0, 2).reshape(b, h, n, dv)
    return y, s_final


def bidirectional_retention(q, k, v, lg_fwd, lg_bwd, s_fwd, s_bwd):
    y_f, s_f = retention_scan(q, k, v, lg_fwd, s_fwd)
    y_b_rev, s_b = retention_scan(jnp.flip(q, 2), jnp.flip(k, 2), jnp.flip(v, 2), lg_bwd, s_bwd)
    return y_f + jnp.flip(y_b_rev, 2), s_f, s_b


def ret_output(y, g, w_out):
    b, h, n, dv = y.shape
    yf = y.astype(jnp.float32)
    mu = jnp.mean(yf, axis=-1, keepdims=True)
    var = jnp.mean(jnp.square(yf - mu), axis=-1, keepdims=True)
    yn = ((yf - mu) * lax.rsqrt(var + NORM_EPS)).astype(g.dtype)
    yn = yn.transpose(0, 2, 1, 3).reshape(b, n, h * dv)
    return (jax.nn.silu(g) * yn) @ w_out


def retention_layer(h_lat, h_ctx, w_in, w_out, decay, cos, sin, need_ctx_out):
    lg = -jnp.abs(decay.astype(jnp.float32))
    qc, kc, vc, gc = ret_project(h_ctx, w_in)
    zeros = jnp.zeros((h_ctx.shape[0], RET_HEADS, RET_QK_DIM, RET_V_DIM), vc.dtype)
    yc, s_f, s_b = bidirectional_retention(qc, kc, vc, lg[0], lg[1], zeros, zeros)
    ql, kl, vl, gl = ret_project(h_lat, w_in)
    ql = apply_rope(ql, cos, sin)
    kl = apply_rope(kl, cos, sin)
    yl, _, _ = bidirectional_retention(ql, kl, vl, lg[0], lg[1], s_f, s_b)
    y_lat = ret_output(yl, gl, w_out)
    y_ctx = ret_output(yc, gc, w_out) if need_ctx_out else None
    return y_lat, y_ctx


def setup_inputs(seed: int = 0) -> dict:
    key = jax.random.key(seed)
    ks = jax.random.split(key, 16)
    f32 = jnp.float32
    base_rate = -np.log(1.0 - 2.0 ** (-5.0 - np.arange(RET_HEADS, dtype=np.float32)))
    base_rate = jnp.asarray(base_rate, dtype=f32)
    return {
        "x": jax.random.normal(ks[0], (BATCH, SEQ, D_MODEL), f32),
        "c": jax.random.normal(ks[1], (BATCH, D_MODEL), f32),
        "ctx": jax.random.normal(ks[2], (BATCH, CTX_LEN, D_MODEL), f32),
        "c_ctx": jax.random.normal(ks[3], (D_MODEL,), f32),
        "ada_w": jax.random.normal(ks[4], (DEPTH, D_MODEL, N_MOD * D_MODEL), f32) * (0.5 * D_MODEL ** -0.5),
        "ada_b": jax.random.normal(ks[5], (DEPTH, N_MOD * D_MODEL), f32) * 0.01,
        "norm_g": 1.0 + 0.02 * jax.random.normal(ks[6], (DEPTH, 3, D_MODEL), f32),
        "final_g": 1.0 + 0.02 * jax.random.normal(ks[7], (D_MODEL,), f32),
        "ffn_w_gate": jax.random.normal(ks[8], (DEPTH, 2, D_MODEL, FFN_DIM), f32) * D_MODEL ** -0.5,
        "ffn_w_up": jax.random.normal(ks[9], (DEPTH, 2, D_MODEL, FFN_DIM), f32) * D_MODEL ** -0.5,
        "ffn_w_down": jax.random.normal(ks[10], (DEPTH, 2, FFN_DIM, D_MODEL), f32) * FFN_DIM ** -0.5,
        "four_w": jax.random.normal(ks[11], (N_FOURIER_LAYERS, D_MODEL, D_MODEL), f32) * D_MODEL ** -0.5,
        "four_b": jax.random.normal(ks[12], (N_FOURIER_LAYERS, D_MODEL), f32) * 0.01,
        "ret_w_in": jax.random.normal(ks[13], (N_RET_LAYERS, D_MODEL, RET_IN_DIM), f32) * D_MODEL ** -0.5,
        "ret_w_out": jax.random.normal(ks[14], (N_RET_LAYERS, RET_V_TOTAL, D_MODEL), f32) * RET_V_TOTAL ** -0.5,
        "ret_decay": base_rate * (1.0 + 0.05 * jax.random.normal(ks[15], (N_RET_LAYERS, 2, RET_HEADS), f32)),
    }


def reference(x, c, ctx, c_ctx, ada_w, ada_b, norm_g, final_g, ffn_w_gate, ffn_w_up, ffn_w_down,
              four_w, four_b, ret_w_in, ret_w_out, ret_decay):
    cos, sin = axial_rope(x.shape[1])
    silu_c = jax.nn.silu(c)
    silu_cc = jax.nn.silu(c_ctx)
    for l in range(DEPTH):
        last = l == DEPTH - 1
        mixer = l % N_MIXERS
        slot = l // N_MIXERS
        ctx_read = (not last) or (mixer == 1)
        m_lat = jnp.split((silu_c @ ada_w[l] + ada_b[l])[:, None, :], N_MOD, axis=-1)
        m_ctx = jnp.split(silu_cc @ ada_w[l] + ada_b[l], N_MOD, axis=-1)

        def half_ffn(t, m, j):
            h = modulate(rmsnorm(t, norm_g[l, j]), m[3 * j], m[3 * j + 1])
            return t + 0.5 * m[3 * j + 2] * swiglu(h, ffn_w_gate[l, j // 2], ffn_w_up[l, j // 2],
                                                  ffn_w_down[l, j // 2])

        x = half_ffn(x, m_lat, 0)
        if ctx_read:
            ctx = half_ffn(ctx, m_ctx, 0)

        h_lat = modulate(rmsnorm(x, norm_g[l, 1]), m_lat[3], m_lat[4])
        h_ctx = modulate(rmsnorm(ctx, norm_g[l, 1]), m_ctx[3], m_ctx[4]) if ctx_read else None
        if mixer == 0:
            y_lat, y_ctx = fourier_layer(h_lat, h_ctx, four_w[slot], four_b[slot])
        else:
            y_lat, y_ctx = retention_layer(h_lat, h_ctx, ret_w_in[slot], ret_w_out[slot], ret_decay[slot],
                                           cos, sin, not last)
        x = x + m_lat[5] * y_lat
        if not last:
            ctx = ctx + m_ctx[5] * y_ctx

        x = half_ffn(x, m_lat, 2)
        if not last:
            ctx = half_ffn(ctx, m_ctx, 2)
    return rmsnorm(x, final_g)
```

```cpp
#include <hip/hip_runtime.h>
#include <hip/hip_cooperative_groups.h>
#include <cstdio>
namespace cg = cooperative_groups;

typedef _Float16 h16;
typedef __attribute__((ext_vector_type(8))) _Float16 h16x8;
typedef __attribute__((ext_vector_type(4))) _Float16 h16x4;
typedef __attribute__((ext_vector_type(4))) float f32x4;

#define NLAT 32768
#define NCTX 512
#define MT 33280
#define NMT 260
#define FF 2816
#define LDK 72

struct Params {
  const float *x, *c, *ctx, *c_ctx, *ada_w, *ada_b, *norm_g, *final_g, *wg, *wu, *wd, *four_w, *four_b, *rwi, *rwo, *rdec;
  float* out;
  char* ws;
};

constexpr size_t AL(size_t x) { return (x + 255) & ~size_t(255); }
constexpr size_t OFF_MODS = 0;
constexpr size_t OFF_D1 = OFF_MODS + AL(4 * 3 * 9216 * 4);
constexpr size_t OFF_D2 = OFF_D1 + AL(256 * 128 * 2);
constexpr size_t OFF_D3 = OFF_D2 + AL(256 * 256 * 2);
constexpr size_t OFF_TW = OFF_D3 + AL(512 * 256 * 2);
constexpr size_t OFF_ROPE = OFF_TW + AL(128 * 128 * 2 * 4);
constexpr size_t OFF_CTXX = OFF_ROPE + AL(256 * 64 * 2 * 4);
constexpr size_t OFF_GN = OFF_CTXX + AL(512 * 1024 * 4);
constexpr size_t OFF_WF = OFF_GN + AL(33280 * 4 * 2 * 4);
constexpr size_t OFF_WGU0 = OFF_WF + AL(2 * 1024 * 2048 * 2);
constexpr size_t OFF_WD0 = OFF_WGU0 + AL(5632 * 1024 * 2);
constexpr size_t OFF_WGU1 = OFF_WD0 + AL(1024 * 2816 * 2);
constexpr size_t OFF_WD1 = OFF_WGU1 + AL(5632 * 1024 * 2);
constexpr size_t OFF_WRI = OFF_WD1 + AL(1024 * 2816 * 2);
constexpr size_t OFF_WRO = OFF_WRI + AL(6144 * 1024 * 2);
constexpr size_t OFF_R0 = OFF_WRO + AL(1024 * 2048 * 2);
constexpr size_t SZ_Y = (size_t)33280 * 2048 * 2;
constexpr size_t OFF_ACT = OFF_R0;
constexpr size_t OFF_AP = OFF_R0;
constexpr size_t OFF_FH = OFF_R0 + SZ_Y;
constexpr size_t OFF_Q = OFF_R0;
constexpr size_t OFF_KT = OFF_Q + (size_t)33280 * 1024 * 2;
constexpr size_t OFF_VT = OFF_KT + (size_t)33280 * 1024 * 2;
#ifdef DIAG_YSRC
constexpr size_t OFF_Y1 = OFF_R0;
#else
constexpr size_t OFF_Y1 = OFF_R0 + 2 * SZ_Y;
#endif
constexpr size_t OFF_Y2 = OFF_R0 + 3 * SZ_Y;
constexpr size_t OFF_H = OFF_Y2;
constexpr size_t OFF_BAR = OFF_R0 + 4 * SZ_Y;
constexpr size_t WS_NEED = OFF_BAR + 16384;

#define SMEM_BYTES 73728
#define ROPE_INLINE 1
#define DIAG_SWAP 0

__device__ __forceinline__ float silu_f(float v) { return v / (1.f + __expf(-v)); }

#define LD_FOREACH(X) X(0, r0) X(1, r1) X(2, r2) X(3, r3) X(4, r4) X(5, r5) X(6, r6) X(7, r7)
template <int ROWS, bool SCALE>
struct LdRM {
  static constexpr int N = ROWS / 32;
  static constexpr bool kSwz = false;
  const h16* src; long ld; const float* ks; int k0;
  uint4 r0, r1, r2, r3, r4, r5, r6, r7;
  __device__ __forceinline__ void init(const h16* s, long l, const float* kscale = nullptr) { src = s; ld = l; ks = kscale; k0 = 0; }
  __device__ __forceinline__ void fetch(int kk0, int tid) {
    k0 = kk0;
#define X(i, R) if (i < N) { int v = tid + i * 256; int r = v >> 3, kv = v & 7; R = *(const uint4*)(src + (long)r * ld + kk0 + kv * 8); }
    LD_FOREACH(X)
#undef X
  }
  __device__ __forceinline__ void commit1(h16* s, int tid, int i, uint4 R) {
    int v = tid + i * 256; int r = v >> 3, kv = v & 7;
    if (SCALE) {
      h16x8 hv = __builtin_bit_cast(h16x8, R);
      h16x8 o;
#pragma unroll
      for (int e = 0; e < 8; ++e) o[e] = (h16)((float)hv[e] * ks[k0 + kv * 8 + e]);
      *(h16x8*)(s + r * LDK + kv * 8) = o;
    } else {
      *(uint4*)(s + r * LDK + kv * 8) = R;
    }
  }
  __device__ __forceinline__ void commit(h16* s, int tid) {
#define X(i, R) if (i < N) commit1(s, tid, i, R);
    LD_FOREACH(X)
#undef X
  }
  __device__ __forceinline__ const h16* slice(const h16* sdef, int) const { return sdef; }
  __device__ __forceinline__ int lds() const { return LDK; }
};

typedef __attribute__((ext_vector_type(2))) _Float16 h16x2;
template <int ROWS>
struct LdTR {
  static_assert(ROWS == 128, "LdTR is written for 128-row tiles");
  static constexpr bool kSwz = true;
  const h16* src; long ld;
  uint4 r0, r1, r2, r3;
  __device__ __forceinline__ void init(const h16* s, long l) { src = s; ld = l; }
  __device__ __forceinline__ void fetch(int kk0, int tid) {
    { int kp = tid >> 4, rv = tid & 15; const h16* p = src + (long)(kk0 + 2 * kp) * ld + rv * 8; r0 = *(const uint4*)p; r1 = *(const uint4*)(p + ld); }
    { int kp = (tid >> 4) + 16, rv = tid & 15; const h16* p = src + (long)(kk0 + 2 * kp) * ld + rv * 8; r2 = *(const uint4*)p; r3 = *(const uint4*)(p + ld); }
  }
  __device__ __forceinline__ void commit2(h16* s, int kp, int rv, uint4 A, uint4 B) {
    h16x8 ha = __builtin_bit_cast(h16x8, A), hb = __builtin_bit_cast(h16x8, B);
    const int k = 2 * kp;
    const int kpos = (((k >> 3) ^ (rv & 7)) << 3) | (k & 7);
#pragma unroll
    for (int e = 0; e < 8; ++e) { h16x2 pk = {ha[e], hb[e]}; *(h16x2*)(s + (rv * 8 + e) * LDK + kpos) = pk; }
  }
  __device__ __forceinline__ void commit(h16* s, int tid) {
    commit2(s, tid >> 4, tid & 15, r0, r1);
    commit2(s, (tid >> 4) + 16, tid & 15, r2, r3);
  }
  __device__ __forceinline__ const h16* slice(const h16* sdef, int) const { return sdef; }
  __device__ __forceinline__ int lds() const { return LDK; }
};

struct LdRes {
  static constexpr bool kSwz = false;
  const h16* base; int ld;
  __device__ __forceinline__ void fetch(int, int) {}
  __device__ __forceinline__ void commit(h16*, int) {}
  __device__ __forceinline__ const h16* slice(const h16*, int s) const { return base + s * 64; }
  __device__ __forceinline__ int lds() const { return ld; }
};

template <int WM, int WN, bool SWA = false, bool SWB = false>
__device__ __forceinline__ void mma64(f32x4 (&acc)[WM][WN], const h16* pa, int lda, const h16* pb, int ldb, int fr, int fq) {
  const int fx = fr >> 3;
#pragma unroll
  for (int ks = 0; ks < 2; ++ks) {
    h16x8 a[WM], b[WN];
#pragma unroll
    for (int m = 0; m < WM; ++m) a[m] = *(const h16x8*)(pa + (m * 16 + fr) * lda + (SWA ? (((ks * 4 + fq) ^ ((2 * m + fx) & 7)) * 8) : (ks * 32 + fq * 8)));
#pragma unroll
    for (int n = 0; n < WN; ++n) b[n] = *(const h16x8*)(pb + (n * 16 + fr) * ldb + (SWB ? (((ks * 4 + fq) ^ ((2 * n + fx) & 7)) * 8) : (ks * 32 + fq * 8)));

#pragma unroll
    for (int m = 0; m < WM; ++m)
#pragma unroll
      for (int n = 0; n < WN; ++n) acc[m][n] = __builtin_amdgcn_mfma_f32_16x16x32_f16(a[m], b[n], acc[m][n], 0, 0, 0);

  }
}

template <int WM, int WN, int WR, int WC, class LA, class LB>
__device__ __forceinline__ void gemm_stream(f32x4 (&acc)[WM][WN], LA& la, LB& lb, int nslices, h16* sA, h16* sB, int tid) {
  const int wid = tid >> 6, lane = tid & 63, fr = lane & 15, fq = lane >> 4;
  const int wr = wid / WC, wc = wid % WC;
  la.fetch(0, tid); lb.fetch(0, tid);
  for (int s = 0; s < nslices; ++s) {
    la.commit(sA, tid); lb.commit(sB, tid);
    __syncthreads();
    if (s + 1 < nslices) { la.fetch((s + 1) * 64, tid); lb.fetch((s + 1) * 64, tid); }
    const h16* pa = la.slice(sA, s) + (wr * 16 * WM) * la.lds();
    const h16* pb = lb.slice(sB, s) + (wc * 16 * WN) * lb.lds();
    mma64<WM, WN, LA::kSwz, LB::kSwz>(acc, pa, la.lds(), pb, lb.lds(), fr, fq);
    __syncthreads();
  }
}

struct Ld2 {
  const h16* tp; long rs;
  uint4 a0, a1, a2, a3, b0, b1, b2, b3;
  __device__ __forceinline__ void init(const h16* src, long ld, int tid) { tp = src + (long)(tid >> 3) * ld + (tid & 7) * 8; rs = 32 * ld; }
  __device__ __forceinline__ void fetchA(int k) {
    a0 = *(const uint4*)(tp + k); a1 = *(const uint4*)(tp + rs + k); a2 = *(const uint4*)(tp + 2 * rs + k); a3 = *(const uint4*)(tp + 3 * rs + k);
  }
  __device__ __forceinline__ void fetchB(int k) {
    b0 = *(const uint4*)(tp + k); b1 = *(const uint4*)(tp + rs + k); b2 = *(const uint4*)(tp + 2 * rs + k); b3 = *(const uint4*)(tp + 3 * rs + k);
  }
  __device__ __forceinline__ void commitA(h16* s, int tid) {
    h16* d = s + (tid >> 3) * 64 + (((tid & 7) ^ ((tid >> 4) & 7)) * 8);
    *(uint4*)d = a0; *(uint4*)(d + 32 * 64) = a1; *(uint4*)(d + 64 * 64) = a2; *(uint4*)(d + 96 * 64) = a3;
  }
  __device__ __forceinline__ void commitB(h16* s, int tid) {
    h16* d = s + (tid >> 3) * 64 + (((tid & 7) ^ ((tid >> 4) & 7)) * 8);
    *(uint4*)d = b0; *(uint4*)(d + 32 * 64) = b1; *(uint4*)(d + 64 * 64) = b2; *(uint4*)(d + 96 * 64) = b3;
  }
};

__device__ __forceinline__ void ldfr(h16x8 (&a)[4], h16x8 (&b)[4], const h16* pa, const h16* pb, int fr, int co) {
#pragma unroll
  for (int m = 0; m < 4; ++m) a[m] = *(const h16x8*)(pa + (m * 16 + fr) * 64 + co);
#pragma unroll
  for (int n = 0; n < 4; ++n) b[n] = *(const h16x8*)(pb + (n * 16 + fr) * 64 + co);
}
__device__ __forceinline__ void mfma16(f32x4 (&acc)[4][4], const h16x8 (&a)[4], const h16x8 (&b)[4]) {
  __builtin_amdgcn_s_setprio(1);
#pragma unroll
  for (int m = 0; m < 4; ++m)
#pragma unroll
    for (int n = 0; n < 4; ++n) acc[m][n] = __builtin_amdgcn_mfma_f32_16x16x32_f16(a[m], b[n], acc[m][n], 0, 0, 0);
  __builtin_amdgcn_s_setprio(0);
}

__device__ __forceinline__ void g2_prefetch(Ld2& la, Ld2& lb) { la.fetchA(0); lb.fetchA(0); }
template <bool PREFETCHED>
__device__ __forceinline__ void gemm_stream2t(f32x4 (&acc)[4][4], Ld2& la, Ld2& lb, int nslices, h16* sm, int tid) {
  h16* sA0 = sm; h16* sB0 = sA0 + 128 * 64; h16* sA1 = sB0 + 128 * 64; h16* sB1 = sA1 + 128 * 64;
  const int wid = tid >> 6, lane = tid & 63, fr = lane & 15, fq = lane >> 4;
  const int wr = wid >> 1, wc = wid & 1;
  const int c0 = (fq ^ ((fr >> 1) & 7)) * 8, c1 = c0 ^ 32;
  const h16* pa0 = sA0 + (wr * 64) * 64; const h16* pb0 = sB0 + (wc * 64) * 64;
  const h16* pa1 = sA1 + (wr * 64) * 64; const h16* pb1 = sB1 + (wc * 64) * 64;
  if (!PREFETCHED) g2_prefetch(la, lb);
  la.commitA(sA0, tid); lb.commitA(sB0, tid);
  la.fetchA(64); lb.fetchA(64);
  __syncthreads();
  h16x8 a0[4], b0[4], a1[4], b1[4];
  ldfr(a0, b0, pa0, pb0, fr, c0);
  for (int s = 0; s < nslices; s += 2) {
    ldfr(a1, b1, pa0, pb0, fr, c1);
    mfma16(acc, a0, b0);
    la.commitA(sA1, tid); lb.commitA(sB1, tid);
    if (s + 2 < nslices) { la.fetchA((s + 2) * 64); lb.fetchA((s + 2) * 64); }
    __syncthreads();
    ldfr(a0, b0, pa1, pb1, fr, c0);
    mfma16(acc, a1, b1);
    ldfr(a1, b1, pa1, pb1, fr, c1);
    mfma16(acc, a0, b0);
    if (s + 2 < nslices) {
      la.commitA(sA0, tid); lb.commitA(sB0, tid);
      la.fetchA((s + 3) * 64); lb.fetchA((s + 3) * 64);
    }
    __syncthreads();
    if (s + 2 < nslices) ldfr(a0, b0, pa0, pb0, fr, c0);
    mfma16(acc, a1, b1);
  }
  __syncthreads();
}
__device__ __forceinline__ void gemm_stream2(f32x4 (&acc)[4][4], Ld2& la, Ld2& lb, int nslices, h16* sm, int tid) {
  gemm_stream2t<false>(acc, la, lb, nslices, sm, tid);
}

struct XcdWalk {
  int xcd, li, nloc;
  __device__ __forceinline__ void init() { xcd = blockIdx.x & 7; li = blockIdx.x >> 3; nloc = (gridDim.x - xcd + 7) >> 3; }
};

template <int WM, int WN>
__device__ __forceinline__ void acc_zero(f32x4 (&acc)[WM][WN]) {
#pragma unroll
  for (int m = 0; m < WM; ++m)
#pragma unroll
    for (int n = 0; n < WN; ++n) acc[m][n] = f32x4{0.f, 0.f, 0.f, 0.f};
}

__device__ __forceinline__ int modset(int row) { return row < 16384 ? 0 : (row < NLAT ? 1 : 2); }
__device__ __forceinline__ const float* mod_ptr(const Params& p, int l, int s, int idx) {
  return (const float*)(p.ws + OFF_MODS) + ((long)(l * 3 + s) * 9216 + idx * 1024);
}
__device__ __forceinline__ const float* res_src(const Params& p, bool first, int row) {
  if (row < NLAT) return (first ? p.x : (const float*)p.out) + (long)row * 1024;
  return (first ? p.ctx : (const float*)(p.ws + OFF_CTXX)) + (long)(row - NLAT) * 1024;
}
__device__ __forceinline__ float* res_dst(const Params& p, int row) {
  if (row < NLAT) return p.out + (long)row * 1024;
  return (float*)(p.ws + OFF_CTXX) + (long)(row - NLAT) * 1024;
}
__device__ __forceinline__ float wave_sum(float v, int lane) {
#pragma unroll
  for (int o = 32; o > 0; o >>= 1) v += __int_as_float(__builtin_amdgcn_ds_bpermute((lane ^ o) << 2, __float_as_int(v)));
  return v;
}

__device__ __forceinline__ void phase_prep(const Params& p, char* smem, int tid) {
  const float PI2 = 6.283185307179586f;
  long gt = (long)blockIdx.x * 256 + tid, gs = (long)gridDim.x * 256;
  h16* D1 = (h16*)(p.ws + OFF_D1); h16* D2 = (h16*)(p.ws + OFF_D2); h16* D3 = (h16*)(p.ws + OFF_D3);
  float* TW = (float*)(p.ws + OFF_TW); float* RP = (float*)(p.ws + OFF_ROPE);
  const float is128 = 0.08838834764831845f;
  for (long i = gt; i < 256 * 128; i += gs) {
    int m = (int)(i >> 7), n1 = (int)(i & 127); int k1 = m >> 1, c = m & 1;
    float a = (float)((k1 * n1) & 127) * (1.f / 64.f);
    D1[i] = (h16)((c == 0 ? cospif(a) : -sinpif(a)) * is128);
  }
  for (long i = gt; i < 256 * 256; i += gs) {
    int m = (int)(i >> 8), kk = (int)(i & 255); int k2 = m >> 1, cp = m & 1, n2 = kk >> 1, c = kk & 1;
    float a = (float)((k2 * n2) & 127) * (1.f / 64.f);
    float C = cospif(a), S = sinpif(a);
    float v = (cp == 0) ? (c == 0 ? C : S) : (c == 0 ? -S : C);
    D2[i] = (h16)(v * is128);
  }
  for (long i = gt; i < 512 * 256; i += gs) {
    int m = (int)(i >> 8), n = (int)(i & 255); int k = m >> 1, c = m & 1;
    float a = (float)((k * n) & 255) * (1.f / 128.f);
    D3[i] = (h16)((c == 0 ? cospif(a) : -sinpif(a)) * 0.0625f);
  }
  for (long i = gt; i < 128 * 128; i += gs) {
    int k1 = (int)(i >> 7), n2 = (int)(i & 127);
    float a = (float)(k1 * n2) * (1.f / 8192.f);
    TW[2 * i] = cospif(a); TW[2 * i + 1] = sinpif(a);
  }
  float* sv = (float*)smem;
  float* red = sv + 3072;
  float* ctab = red + 768;
  float* stab = ctab + 256;
  for (int job = blockIdx.x; job < 576 + 1024; job += gridDim.x) {
    __syncthreads();
    if (job < 576) {
      int l = job / 144, colbase = (job % 144) * 64;
      for (int i = tid; i < 3072; i += 256) {
        int s = i >> 10, d = i & 1023;
        float cv = (s < 2) ? p.c[s * 1024 + d] : p.c_ctx[d];
        sv[i] = silu_f(cv);
      }
      __syncthreads();
      int col = tid & 63, dq = tid >> 6;
      float a0 = 0.f, a1 = 0.f, a2 = 0.f;
      const float* w = p.ada_w + ((long)l * 1024 + dq * 256) * 9216 + colbase + col;
#pragma unroll 32
      for (int d = 0; d < 256; ++d) {
        float wv = w[(long)d * 9216];
        int dd = dq * 256 + d;
        a0 += sv[dd] * wv; a1 += sv[1024 + dd] * wv; a2 += sv[2048 + dd] * wv;
      }
      red[(0 * 4 + dq) * 64 + col] = a0; red[(1 * 4 + dq) * 64 + col] = a1; red[(2 * 4 + dq) * 64 + col] = a2;
      __syncthreads();
      if (tid < 192) {
        int s = tid >> 6, cc = tid & 63;
        float v = red[(s * 4 + 0) * 64 + cc] + red[(s * 4 + 1) * 64 + cc] + red[(s * 4 + 2) * 64 + cc] + red[(s * 4 + 3) * 64 + cc];
        v += p.ada_b[l * 9216 + colbase + cc];
        ((float*)(p.ws + OFF_MODS))[(long)(l * 3 + s) * 9216 + colbase + cc] = v;
      }
    } else {
      int f = job - 576;
      int slot = f >> 9, r = f & 511, t = r >> 8, r2 = r & 255, g = r2 >> 6, r3 = r2 & 63, ct = r3 >> 2, ot = r3 & 3;
      ctab[tid] = cospif((float)tid * (1.f / 128.f)); stab[tid] = sinpif((float)tid * (1.f / 128.f));
      __syncthreads();
      const float* tab = t == 0 ? ctab : stab;
      int o = ot * 256 + tid;
      float acc[16];
#pragma unroll
      for (int ci = 0; ci < 16; ++ci) acc[ci] = 0.f;
      const float* W = p.four_w + ((long)slot * 1024 + g * 256) * 1024 + o;
#pragma unroll 32
      for (int m = 0; m < 256; ++m) {
        float wv = W[(long)m * 1024];
#pragma unroll
        for (int ci = 0; ci < 16; ++ci) acc[ci] += wv * tab[(m * (ct * 16 + ci)) & 255];
      }
      h16* dst = (h16*)(p.ws + OFF_WF) + ((long)slot * 1024 + o) * 2048 + t * 1024 + g * 256 + ct * 16;
      h16x8 o0, o1;
#pragma unroll
      for (int e = 0; e < 8; ++e) { o0[e] = (h16)(acc[e] * 0.0625f); o1[e] = (h16)(acc[8 + e] * 0.0625f); }
      *(h16x8*)dst = o0; *(h16x8*)(dst + 8) = o1;
    }
  }
}

__device__ __forceinline__ int conv_map(int mode, int n) {
  if (mode == 0) return n;
  if (mode == 1 || mode == 2) return (n >> 6) * 128 + ((n & 63) >> 4) * 32 + (mode == 2 ? 16 : 0) + (n & 15);
  if (n >= 2048) return n;
  int sec = n >> 10, hh = (n & 1023) >> 8, i = n & 255, half = i >> 7, ii = i & 127;
  return sec * 1024 + hh * 256 + (ii >> 6) * 128 + ((ii & 63) >> 4) * 32 + half * 16 + (ii & 15);
}
struct ConvJob { const float* src; long src_ld; h16* dst; long dst_ld; int k0, n0, mode; };
__device__ __forceinline__ ConvJob conv_decode(const Params& p, int l, int job) {
  ConvJob c;
  const int slot = l >> 1;
  if (job < 4224) {
    int seg = job / 704, r = job % 704; int f = seg / 3, kind = seg % 3;
    if (kind < 2) {
      c.src = (kind == 0 ? p.wg : p.wu) + (long)(l * 2 + f) * 1024 * FF; c.src_ld = FF;
      c.dst = (h16*)(p.ws + (f == 0 ? OFF_WGU0 : OFF_WGU1)); c.dst_ld = 1024;
      c.k0 = (r / 44) * 64; c.n0 = (r % 44) * 64; c.mode = kind == 0 ? 1 : 2;
    } else {
      c.src = p.wd + (long)(l * 2 + f) * FF * 1024; c.src_ld = 1024;
      c.dst = (h16*)(p.ws + (f == 0 ? OFF_WD0 : OFF_WD1)); c.dst_ld = FF;
      c.k0 = (r / 16) * 64; c.n0 = (r % 16) * 64; c.mode = 0;
    }
  } else {
    int r = job - 4224;
    if (r < 1536) {
      c.src = p.rwi + (long)slot * 1024 * 6144; c.src_ld = 6144; c.dst = (h16*)(p.ws + OFF_WRI); c.dst_ld = 1024;
      c.k0 = (r / 96) * 64; c.n0 = (r % 96) * 64; c.mode = 3;
    } else {
      r -= 1536;
      c.src = p.rwo + (long)slot * 2048 * 1024; c.src_ld = 1024; c.dst = (h16*)(p.ws + OFF_WRO); c.dst_ld = 2048;
      c.k0 = (r / 16) * 64; c.n0 = (r % 16) * 64; c.mode = 0;
    }
  }
  return c;
}
__device__ __forceinline__ void conv_load(const ConvJob& c, int tid, float4& v0, float4& v1, float4& v2, float4& v3) {
  const float* s0 = c.src + (long)(c.k0 + (tid >> 4)) * c.src_ld + c.n0 + (tid & 15) * 4;
  v0 = *(const float4*)s0; v1 = *(const float4*)(s0 + 16 * c.src_ld); v2 = *(const float4*)(s0 + 32 * c.src_ld); v3 = *(const float4*)(s0 + 48 * c.src_ld);
}
__device__ __forceinline__ void conv_store(const ConvJob& c, float* tile, int tid, float4 v0, float4 v1, float4 v2, float4 v3) {
  {
    float* t = tile + (tid >> 4) * 65 + (tid & 15) * 4;
    t[0] = v0.x; t[1] = v0.y; t[2] = v0.z; t[3] = v0.w;
    t[16 * 65] = v1.x; t[16 * 65 + 1] = v1.y; t[16 * 65 + 2] = v1.z; t[16 * 65 + 3] = v1.w;
    t[32 * 65] = v2.x; t[32 * 65 + 1] = v2.y; t[32 * 65 + 2] = v2.z; t[32 * 65 + 3] = v2.w;
    t[48 * 65] = v3.x; t[48 * 65 + 1] = v3.y; t[48 * 65 + 2] = v3.z; t[48 * 65 + 3] = v3.w;
  }
  __syncthreads();
  int nn = tid >> 2, kq = (tid & 3) * 16;
  h16x8 o0, o1;
#pragma unroll
  for (int e = 0; e < 8; ++e) { o0[e] = (h16)tile[(kq + e) * 65 + nn]; o1[e] = (h16)tile[(kq + 8 + e) * 65 + nn]; }
  int drow = conv_map(c.mode, c.n0 + nn);
  h16* d = c.dst + (long)drow * c.dst_ld + c.k0 + kq;
  *(h16x8*)d = o0; *(h16x8*)(d + 8) = o1;
  __syncthreads();
}

__device__ __forceinline__ void phase_norm(const Params& p, int l, int j, bool first, int extra, char* smem, int tid) {
  const int wid = tid >> 6, lane = tid & 63;
  h16* H = (h16*)(p.ws + OFF_H);
  const float* g = p.norm_g + (l * 3 + j) * 1024;
  for (int row0 = (blockIdx.x * 4 + wid) * 4; row0 < MT; row0 += gridDim.x * 16) {
    float4 v[4][4]; float ss[4];
#pragma unroll
    for (int r = 0; r < 4; ++r) {
      const float* xr = res_src(p, first, row0 + r);
#pragma unroll
      for (int i = 0; i < 4; ++i) v[r][i] = ((const float4*)xr)[lane + 64 * i];
    }
#pragma unroll
    for (int r = 0; r < 4; ++r) {
      float a = 0.f;
#pragma unroll
      for (int i = 0; i < 4; ++i) a += v[r][i].x * v[r][i].x + v[r][i].y * v[r][i].y + v[r][i].z * v[r][i].z + v[r][i].w * v[r][i].w;
      ss[r] = rsqrtf(wave_sum(a, lane) * (1.f / 1024.f) + 1e-6f);
    }
    int s = modset(row0);
    const float* sh = mod_ptr(p, l, s, 3 * j);
    const float* sc = mod_ptr(p, l, s, 3 * j + 1);
#pragma unroll
    for (int i = 0; i < 4; ++i) {
      int c4 = lane + 64 * i;
      float4 gg = ((const float4*)g)[c4], s4 = ((const float4*)sh)[c4], c4v = ((const float4*)sc)[c4];
#pragma unroll
      for (int r = 0; r < 4; ++r) {
        h16x4 o;
        o[0] = (h16)(((v[r][i].x * ss[r]) * gg.x) * (1.f + c4v.x) + s4.x);
        o[1] = (h16)(((v[r][i].y * ss[r]) * gg.y) * (1.f + c4v.y) + s4.y);
        o[2] = (h16)(((v[r][i].z * ss[r]) * gg.z) * (1.f + c4v.z) + s4.z);
        o[3] = (h16)(((v[r][i].w * ss[r]) * gg.w) * (1.f + c4v.w) + s4.w);
        *(h16x4*)(H + (long)(row0 + r) * 1024 + c4 * 4) = o;
      }
    }
  }
  if (extra == 1) {
    float* tile = (float*)smem;
    const bool ret = (l & 1) == 1;
    const int njobs = 6 * 704 + (ret ? 2048 : 0);
    int job = blockIdx.x;
    float4 c0, c1, c2, c3;
    ConvJob cj;
    if (job < njobs) { cj = conv_decode(p, l, job); conv_load(cj, tid, c0, c1, c2, c3); }
    while (job < njobs) {
      const int nj = job + gridDim.x;
      float4 d0 = c0, d1 = c1, d2 = c2, d3 = c3;
      ConvJob cc = cj;
      if (nj < njobs) { cj = conv_decode(p, l, nj); conv_load(cj, tid, c0, c1, c2, c3); }
      conv_store(cc, tile, tid, d0, d1, d2, d3);
      job = nj;
    }
  } else if (extra == 2) {
    const h16* Y1 = (const h16*)(p.ws + OFF_Y1);
    float* gn = (float*)(p.ws + OFF_GN);
    for (int row0 = (blockIdx.x * 4 + wid) * 2; row0 < MT; row0 += gridDim.x * 8) {
      h16x8 hv[2][4];
#pragma unroll
      for (int r = 0; r < 2; ++r)
#pragma unroll
        for (int hh = 0; hh < 4; ++hh) hv[r][hh] = *(const h16x8*)(Y1 + (long)(row0 + r) * 2048 + hh * 512 + lane * 8);
#pragma unroll
      for (int r = 0; r < 2; ++r)
#pragma unroll
        for (int hh = 0; hh < 4; ++hh) {
          float f[8], s = 0.f;
#pragma unroll
          for (int e = 0; e < 8; ++e) { f[e] = (float)hv[r][hh][e]; s += f[e]; }
          s = wave_sum(s, lane);
          float mu = s * (1.f / 512.f), q = 0.f;
#pragma unroll
          for (int e = 0; e < 8; ++e) { float d = f[e] - mu; q += d * d; }
          q = wave_sum(q, lane);
          if (lane == 0) { int w = (row0 + r) * 4 + hh; gn[w * 2] = mu; gn[w * 2 + 1] = rsqrtf(q * (1.f / 512.f) + 1e-6f); }
        }
    }
  }
}

__device__ __forceinline__ void phase_g1(const Params& p, int f, char* smem, int tid) {
  h16* sA = (h16*)smem; h16* sB = sA + 128 * LDK;
  const int wid = tid >> 6, lane = tid & 63, fr = lane & 15, fq = lane >> 4, wr = wid >> 1, wc = wid & 1;
  const h16* H = (const h16*)(p.ws + OFF_H);
  const h16* W = (const h16*)(p.ws + (f == 0 ? OFF_WGU0 : OFF_WGU1));
  h16* act = (h16*)(p.ws + OFF_ACT);
  XcdWalk xw; xw.init();
  const int ng = xw.xcd & 3, mh = xw.xcd >> 2;
  Ld2 la, lb;
  int u = xw.li;
  if (u < 130 * 11) {
    la.init(W + (long)(ng * 11 + u % 11) * 128 * 1024, 1024, tid); lb.init(H + (long)(mh * 130 + u / 11) * 128 * 1024, 1024, tid);
    g2_prefetch(la, lb);
  }
  for (; u < 130 * 11; u += xw.nloc) {
    int mt = mh * 130 + u / 11, nt = ng * 11 + u % 11;
    f32x4 acc[4][4]; acc_zero<4, 4>(acc);
    gemm_stream2t<true>(acc, la, lb, 16, sA, tid);
    {
      int un = u + xw.nloc;
      if (un < 130 * 11) {
        la.init(W + (long)(ng * 11 + un % 11) * 128 * 1024, 1024, tid); lb.init(H + (long)(mh * 130 + un / 11) * 128 * 1024, 1024, tid);
        g2_prefetch(la, lb);
      }
    }
#pragma unroll
    for (int n = 0; n < 4; ++n) {
      long token = mt * 128 + wc * 64 + n * 16 + fr;
      h16* dst = act + token * FF + nt * 64 + fq * 4;
#pragma unroll
      for (int q = 0; q < 2; ++q) {
        h16x4 o;
#pragma unroll
        for (int j = 0; j < 4; ++j) o[j] = (h16)(silu_f(acc[2 * q][n][j]) * acc[2 * q + 1][n][j]);
        *(h16x4*)(dst + (wr * 2 + q) * 16) = o;
      }
    }
  }
}

__device__ __forceinline__ void phase_gemm_res(const Params& p, const h16* A, int K, const h16* B, int l, int gate_idx, float coef, const float* bias,
                               bool first, char* smem, int tid) {
  h16* sA = (h16*)smem;
  const int wid = tid >> 6, lane = tid & 63, fr = lane & 15, fq = lane >> 4, wr = wid >> 1, wc = wid & 1;
  XcdWalk xw; xw.init();
  const int ng = xw.xcd & 1, mq = xw.xcd >> 1;
  Ld2 la, lb;
  int u = xw.li;
  if (u < 256) {
    la.init(B + (long)(4 * ng + (u & 3)) * 128 * K, K, tid); lb.init(A + (long)(mq * 65 + (u >> 2)) * 128 * K, K, tid);
    g2_prefetch(la, lb);
  }
  for (; u < 256; u += xw.nloc) {
    int mt = mq * 65 + (u >> 2), nt = 4 * ng + (u & 3);
    f32x4 acc[4][4]; acc_zero<4, 4>(acc);
    gemm_stream2t<true>(acc, la, lb, K / 64, sA, tid);
    {
      int un = u + xw.nloc;
      if (un < 256) {
        la.init(B + (long)(4 * ng + (un & 3)) * 128 * K, K, tid); lb.init(A + (long)(mq * 65 + (un >> 2)) * 128 * K, K, tid);
        g2_prefetch(la, lb);
      }
    }
    int s = modset(mt * 128);
    const float* gate = mod_ptr(p, l, s, gate_idx);
#pragma unroll
    for (int n = 0; n < 4; ++n) {
      int row = mt * 128 + wc * 64 + n * 16 + fr;
      const float* xs = res_src(p, first, row);
      float* xd = res_dst(p, row);
#pragma unroll
      for (int m = 0; m < 4; ++m) {
        int col = nt * 128 + wr * 64 + m * 16 + fq * 4;
        float4 xv = *(const float4*)(xs + col), g4 = *(const float4*)(gate + col);
        float4 b4 = bias ? *(const float4*)(bias + col) : float4{0.f, 0.f, 0.f, 0.f};
        float4 o;
        o.x = xv.x + coef * g4.x * (acc[m][n][0] + b4.x);
        o.y = xv.y + coef * g4.y * (acc[m][n][1] + b4.y);
        o.z = xv.z + coef * g4.z * (acc[m][n][2] + b4.z);
        o.w = xv.w + coef * g4.w * (acc[m][n][3] + b4.w);
        *(float4*)(xd + col) = o;
      }
    }
  }
  {
    h16* qA = (h16*)smem; h16* qB = (h16*)(smem + 18432);
    const int tid2 = ((wr * 2 + wc) << 6) | (fq << 4) | fr;
    const int w4 = wr * 2 + wc;
    for (int v = xw.li; v < 16; v += xw.nloc) {
      int uu = 256 + (v >> 2), qr = v & 3;
      int mt = mq * 65 + (uu >> 2), nt = 4 * ng + (uu & 3);
      f32x4 acc[2][2]; acc_zero<2, 2>(acc);
      LdRM<128, false> lw; lw.init(B + (long)nt * 128 * K, K);
      LdRM<32, false> lx; lx.init(A + ((long)mt * 128 + qr * 32) * K, K);
      gemm_stream<2, 2, 4, 1>(acc, lw, lx, K / 64, qA, qB, tid2);
      int s = modset(mt * 128);
      const float* gate = mod_ptr(p, l, s, gate_idx);
#pragma unroll
      for (int n = 0; n < 2; ++n) {
        int row = mt * 128 + qr * 32 + n * 16 + fr;
        const float* xs = res_src(p, first, row);
        float* xd = res_dst(p, row);
#pragma unroll
        for (int m = 0; m < 2; ++m) {
          int col = nt * 128 + w4 * 32 + m * 16 + fq * 4;
          float4 xv = *(const float4*)(xs + col), g4 = *(const float4*)(gate + col);
          float4 b4 = bias ? *(const float4*)(bias + col) : float4{0.f, 0.f, 0.f, 0.f};
          float4 o;
          o.x = xv.x + coef * g4.x * (acc[m][n][0] + b4.x);
          o.y = xv.y + coef * g4.y * (acc[m][n][1] + b4.y);
          o.z = xv.z + coef * g4.z * (acc[m][n][2] + b4.z);
          o.w = xv.w + coef * g4.w * (acc[m][n][3] + b4.w);
          *(float4*)(xd + col) = o;
        }
      }
    }
  }
}

__device__ __forceinline__ void phase_s1(const Params& p, char* smem, int tid) {
  h16* sA = (h16*)smem; h16* sB = sA + 128 * LDK;
  const int wid = tid >> 6, lane = tid & 63, fr = lane & 15, fq = lane >> 4, wr = wid >> 1, wc = wid & 1;
  const h16* H = (const h16*)(p.ws + OFF_H);
  h16* AP = (h16*)(p.ws + OFF_AP); h16* FH = (h16*)(p.ws + OFF_FH);
  const float* TW = (const float*)(p.ws + OFF_TW);
  for (int job = blockIdx.x; job < 4096 + 64; job += gridDim.x) {
    f32x4 acc[4][4]; acc_zero<4, 4>(acc);
    if (job < 4096) {
      int mtile = job & 1, ct = (job >> 1) & 7, n2 = (job >> 4) & 127, b = job >> 11;
      LdRM<128, false> la; la.init((const h16*)(p.ws + OFF_D1) + mtile * 128 * 128, 128);
      LdTR<128> lb; lb.init(H + ((long)(b * 16384 + n2) * 1024 + ct * 128), 128 * 1024);
      gemm_stream<4, 4, 2, 2>(acc, la, lb, 2, sA, sB, tid);
#pragma unroll
      for (int m = 0; m < 4; ++m)
#pragma unroll
        for (int jp = 0; jp < 2; ++jp) {
          int row = mtile * 128 + wr * 64 + m * 16 + fq * 4 + 2 * jp; int k1 = row >> 1;
          float c = TW[(k1 * 128 + n2) * 2], s = TW[(k1 * 128 + n2) * 2 + 1];
          h16* d = AP + ((long)(b * 128 + k1) * 256 + 2 * n2) * 1024 + ct * 128 + wc * 64 + fr;
#pragma unroll
          for (int n = 0; n < 4; ++n) {
            float ar = acc[m][n][2 * jp], ai = acc[m][n][2 * jp + 1];
            d[n * 16] = (h16)(ar * c + ai * s);
            d[1024 + n * 16] = (h16)(ai * c - ar * s);
          }
        }
    } else {
      int jc = job - 4096; int mtile = jc & 3, ct = (jc >> 2) & 7, b = jc >> 5;
      LdRM<128, false> la; la.init((const h16*)(p.ws + OFF_D3) + mtile * 128 * 256, 256);
      LdTR<128> lb; lb.init(H + ((long)(NLAT + b * 256) * 1024 + ct * 128), 1024);
      gemm_stream<4, 4, 2, 2>(acc, la, lb, 4, sA, sB, tid);
#pragma unroll
      for (int m = 0; m < 4; ++m)
#pragma unroll
        for (int j = 0; j < 4; ++j) {
          int row = mtile * 128 + wr * 64 + m * 16 + fq * 4 + j; int k = row >> 1, c = row & 1;
          h16* d = FH + (long)(NLAT + b * 256 + k) * 2048 + c * 1024 + ct * 128 + wc * 64 + fr;
#pragma unroll
          for (int n = 0; n < 4; ++n) d[n * 16] = (h16)acc[m][n][j];
        }
    }
  }
}
__device__ __forceinline__ void phase_s2(const Params& p, char* smem, int tid) {
  h16* sA = (h16*)smem; h16* sB = sA + 128 * LDK;
  const int wid = tid >> 6, lane = tid & 63, fr = lane & 15, fq = lane >> 4, wr = wid >> 1, wc = wid & 1;
  const h16* AP = (const h16*)(p.ws + OFF_AP); h16* FH = (h16*)(p.ws + OFF_FH);
  for (int job = blockIdx.x; job < 4096; job += gridDim.x) {
    int mtile = job & 1, ct = (job >> 1) & 7, k1 = (job >> 4) & 127, b = job >> 11;
    f32x4 acc[4][4]; acc_zero<4, 4>(acc);
    LdRM<128, false> la; la.init((const h16*)(p.ws + OFF_D2) + mtile * 128 * 256, 256);
    LdTR<128> lb; lb.init(AP + ((long)(b * 128 + k1) * 256) * 1024 + ct * 128, 1024);
    gemm_stream<4, 4, 2, 2>(acc, la, lb, 4, sA, sB, tid);
#pragma unroll
    for (int m = 0; m < 4; ++m)
#pragma unroll
      for (int j = 0; j < 4; ++j) {
        int row = mtile * 128 + wr * 64 + m * 16 + fq * 4 + j; int k2 = row >> 1, c = row & 1;
        h16* d = FH + (long)(b * 16384 + k1 + 128 * k2) * 2048 + c * 1024 + ct * 128 + wc * 64 + fr;
#pragma unroll
        for (int n = 0; n < 4; ++n) d[n * 16] = (h16)acc[m][n][j];
      }
  }
}

__device__ __forceinline__ void phase_r1(const Params& p, char* smem, int tid) {
  h16* sA = (h16*)smem; h16* sB = sA + 128 * LDK;
  const int wid = tid >> 6, lane = tid & 63, fr = lane & 15, fq = lane >> 4, wr = wid >> 1, wc = wid & 1;
  const h16* H = (const h16*)(p.ws + OFF_H);
  const h16* W = (const h16*)(p.ws + OFF_WRI);
  h16* Q = (h16*)(p.ws + OFF_Q); h16* Kt = (h16*)(p.ws + OFF_KT); h16* Vt = (h16*)(p.ws + OFF_VT);
  const float* RP = (const float*)(p.ws + OFF_ROPE);
  XcdWalk xw; xw.init();
  Ld2 la, lb;
  int u = xw.li;
  if (u < NMT * 4) {
    la.init(H + (long)(u >> 2) * 128 * 1024, 1024, tid); lb.init(W + (long)(xw.xcd * 4 + (u & 3)) * 128 * 1024, 1024, tid);
    g2_prefetch(la, lb);
  }
  for (; u < NMT * 4; u += xw.nloc) {
    int mt = u >> 2, nt = xw.xcd * 4 + (u & 3);
    f32x4 acc[4][4]; acc_zero<4, 4>(acc);
    gemm_stream2t<true>(acc, la, lb, 16, sA, tid);
    {
      int un = u + xw.nloc;
      if (un < NMT * 4) {
        la.init(H + (long)(un >> 2) * 128 * 1024, 1024, tid); lb.init(W + (long)(xw.xcd * 4 + (un & 3)) * 128 * 1024, 1024, tid);
        g2_prefetch(la, lb);
      }
    }
    if (nt < 16) {
      bool isk = nt >= 8; int hh = (nt & 7) >> 1, tt = nt & 1;
      bool lat = mt < 256;
#pragma unroll
      for (int m = 0; m < 4; ++m)
#pragma unroll
        for (int q = 0; q < 2; ++q) {
          int i = tt * 64 + (wc * 2 + q) * 16 + fr;
          float o1[4], o2[4];
#pragma unroll
          for (int j = 0; j < 4; ++j) {
            int row = mt * 128 + wr * 64 + m * 16 + fq * 4 + j;
            float t1 = acc[m][2 * q][j], t2 = acc[m][2 * q + 1][j];
            if (lat) {
              int ntok = row & 16383;
              int pos = (i < 64) ? (ntok >> 6) : (ntok & 63);
              int fi = i & 63;
#ifdef ROPE_INLINE
              float ang = (float)pos * exp2f(-(float)fi * 0.20762050593046014f);
              float c = __cosf(ang), s = __sinf(ang);
#else
              float c = RP[(pos * 64 + fi) * 2], s = RP[(pos * 64 + fi) * 2 + 1];
#endif
              o1[j] = t1 * c - t2 * s; o2[j] = t2 * c + t1 * s;
            } else { o1[j] = t1; o2[j] = t2; }
          }
          if (!isk) {
#pragma unroll
            for (int j = 0; j < 4; ++j) {
              int row = mt * 128 + wr * 64 + m * 16 + fq * 4 + j;
              Q[(long)row * 1024 + hh * 256 + i] = (h16)o1[j];
              Q[(long)row * 1024 + hh * 256 + 128 + i] = (h16)o2[j];
            }
          } else {
            int tok = wr * 64 + m * 16 + fq * 4;
            h16x4 a, b2;
#pragma unroll
            for (int j = 0; j < 4; ++j) { a[j] = (h16)(o1[j] * 0.0625f); b2[j] = (h16)(o2[j] * 0.0625f); }
            *(h16x4*)(Kt + ((long)(mt * 4 + hh) * 256 + i) * 128 + tok) = a;
            *(h16x4*)(Kt + ((long)(mt * 4 + hh) * 256 + 128 + i) * 128 + tok) = b2;
          }
        }
    } else {
#pragma unroll
      for (int m = 0; m < 4; ++m)
#pragma unroll
        for (int n = 0; n < 4; ++n) {
          int v = (nt - 16) * 128 + wc * 64 + n * 16 + fr; int hh = v >> 9, dv = v & 511;
          int tok = wr * 64 + m * 16 + fq * 4;
          h16x4 a;
#pragma unroll
          for (int j = 0; j < 4; ++j) a[j] = (h16)acc[m][n][j];
          *(h16x4*)(Vt + ((long)(mt * 4 + hh) * 512 + dv) * 128 + tok) = a;
        }
    }
  }
}

__device__ __forceinline__ uint4 scale8(uint4 v, float4 s0, float4 s1) {
  h16x8 h = __builtin_bit_cast(h16x8, v); h16x8 o;
  o[0] = (h16)((float)h[0] * s0.x); o[1] = (h16)((float)h[1] * s0.y); o[2] = (h16)((float)h[2] * s0.z); o[3] = (h16)((float)h[3] * s0.w);
  o[4] = (h16)((float)h[4] * s1.x); o[5] = (h16)((float)h[5] * s1.y); o[6] = (h16)((float)h[6] * s1.z); o[7] = (h16)((float)h[7] * s1.w);
  return __builtin_bit_cast(uint4, o);
}
#define R2_LD(p) (*(const uint4*)(p))
#define R2_QFETCH(qb) do { \
    q00 = R2_LD(qb); q01 = R2_LD(qb + 64); q02 = R2_LD(qb + 128); q03 = R2_LD(qb + 192); \
    q10 = R2_LD(qb + 1024); q11 = R2_LD(qb + 1024 + 64); q12 = R2_LD(qb + 1024 + 128); q13 = R2_LD(qb + 1024 + 192); \
    q20 = R2_LD(qb + 2048); q21 = R2_LD(qb + 2048 + 64); q22 = R2_LD(qb + 2048 + 128); q23 = R2_LD(qb + 2048 + 192); \
    q30 = R2_LD(qb + 3072); q31 = R2_LD(qb + 3072 + 64); q32 = R2_LD(qb + 3072 + 128); q33 = R2_LD(qb + 3072 + 192); } while (0)
#define R2_QFETCH01(qb) do { q00 = R2_LD(qb); q01 = R2_LD(qb + 64); q10 = R2_LD(qb + 1024); q11 = R2_LD(qb + 1024 + 64); \
    q20 = R2_LD(qb + 2048); q21 = R2_LD(qb + 2048 + 64); q30 = R2_LD(qb + 3072); q31 = R2_LD(qb + 3072 + 64); } while (0)
#define R2_QFETCH23(qb) do { q02 = R2_LD(qb + 128); q03 = R2_LD(qb + 192); q12 = R2_LD(qb + 1024 + 128); q13 = R2_LD(qb + 1024 + 192); \
    q22 = R2_LD(qb + 2048 + 128); q23 = R2_LD(qb + 2048 + 192); q32 = R2_LD(qb + 3072 + 128); q33 = R2_LD(qb + 3072 + 192); } while (0)
#define R2_QCOMMIT(a, b, c, d) do { *(uint4*)(qd) = a; *(uint4*)(qd + LDK) = b; *(uint4*)(qd + 2 * LDK) = c; *(uint4*)(qd + 3 * LDK) = d; } while (0)
#define R2_KFETCH(kb, k0_, k1_, k2_, k3_, k4_, k5_, k6_, k7_) do { \
    k0_ = R2_LD(kb); k1_ = R2_LD(kb + 128); k2_ = R2_LD(kb + 256); k3_ = R2_LD(kb + 384); \
    k4_ = R2_LD(kb + 512); k5_ = R2_LD(kb + 640); k6_ = R2_LD(kb + 768); k7_ = R2_LD(kb + 896); } while (0)
__device__ __forceinline__ uint4 scale8h(uint4 v, h16x8 sc) {
  h16x8 h = __builtin_bit_cast(h16x8, v);
  h16x8 o = h * sc;
  return __builtin_bit_cast(uint4, o);
}
#define R2_KCOMMIT(sc, k0_, k1_, k2_, k3_, k4_, k5_, k6_, k7_) do { \
    const h16x8 s8_ = *(const h16x8*)(sc); \
    *(uint4*)(kd) = scale8h(k0_, s8_); *(uint4*)(kd + LDK) = scale8h(k1_, s8_); \
    *(uint4*)(kd + 2 * LDK) = scale8h(k2_, s8_); *(uint4*)(kd + 3 * LDK) = scale8h(k3_, s8_); \
    *(uint4*)(kd + 4 * LDK) = scale8h(k4_, s8_); *(uint4*)(kd + 5 * LDK) = scale8h(k5_, s8_); \
    *(uint4*)(kd + 6 * LDK) = scale8h(k6_, s8_); *(uint4*)(kd + 7 * LDK) = scale8h(k7_, s8_); } while (0)
#define R2_QCOMMIT2(a, b, c, d) do { *(uint4*)(qd + 128 * LDK) = a; *(uint4*)(qd + 129 * LDK) = b; *(uint4*)(qd + 130 * LDK) = c; *(uint4*)(qd + 131 * LDK) = d; } while (0)

__device__ __forceinline__ void phase_r2(const Params& p, int slot, char* smem, int tid) {
  h16* sA = (h16*)smem;
  h16* sB = (h16*)(smem + 36864);
  h16* sS = (h16*)(smem + 41472);
  float* ysc = (float*)(smem + 58368);
  h16* ksh = (h16*)(smem + 58880);
  const int wid = tid >> 6, lane = tid & 63, fr = lane & 15, fq = lane >> 4;
  const h16* Q = (const h16*)(p.ws + OFF_Q); const h16* Kt = (const h16*)(p.ws + OFF_KT); const h16* Vt = (const h16*)(p.ws + OFF_VT);
  const int trow = tid >> 3, tkv = tid & 7;
  h16* qd = sA + (trow * 4) * LDK + tkv * 8;
  h16* kd = sA + (trow * 8) * LDK + tkv * 8;
  h16* vd = sB + trow * LDK + tkv * 8;
  for (int job = blockIdx.x; job < 256; job += gridDim.x) {
    int chain = job >> 4, sl = job & 15;
    int b = chain >> 3, hh = (chain >> 1) & 3, dir = chain & 1;
    h16* Yd = (h16*)(p.ws + (dir == 0 ? OFF_Y1 : OFF_Y2));
    float lg = -fabsf(p.rdec[slot * 8 + dir * 4 + hh]);
    __syncthreads();
    if (wid < 2) {
      const int ti = wid * 64 + lane;
      float pp = (float)ti;
      ksh[ti] = (h16)(dir == 0 ? __expf(lg * (127.f - pp)) : __expf(lg * pp));
      ysc[ti] = dir == 0 ? __expf(lg * (pp + 1.f)) : __expf(lg * (128.f - pp));
    }
    float cdec = __expf(lg * 128.f);
    f32x4 S[4][2]; acc_zero<4, 2>(S);
    __syncthreads();
    uint4 q00, q01, q02, q03, q10, q11, q12, q13, q20, q21, q22, q23, q30, q31, q32, q33;
    uint4 ka0, ka1, ka2, ka3, ka4, ka5, ka6, ka7, kb0, kb1, kb2, kb3, kb4, kb5, kb6, kb7, va, vb;
    {
      int cg0 = 256 + b * 2 + (dir == 0 ? 0 : 1);
      const h16* kbp = Kt + ((long)(cg0 * 4 + hh) * 256) * 128 + (trow * 8) * 128 + tkv * 8;
      const h16* vbp = Vt + ((long)(cg0 * 4 + hh) * 512 + sl * 32) * 128 + trow * 128 + tkv * 8;
      R2_KFETCH(kbp, ka0, ka1, ka2, ka3, ka4, ka5, ka6, ka7); va = R2_LD(vbp);
      R2_KFETCH(kbp + 64, kb0, kb1, kb2, kb3, kb4, kb5, kb6, kb7); vb = R2_LD(vbp + 64);
      const h16* qb = Q + (long)cg0 * 128 * 1024 + hh * 256 + (trow * 4) * 1024 + tkv * 8;
      R2_QFETCH(qb);
    }
    for (int st = 0; st < 130; ++st) {
      int cgk, cn = 0;
      if (st < 2) cgk = 256 + b * 2 + (dir == 0 ? st : 1 - st);
      else { int c = st - 2; cgk = b * 128 + (dir == 0 ? c : 127 - c); }
      const bool more = st + 1 < 130;
      if (more) {
        int s1 = st + 1;
        if (s1 < 2) cn = 256 + b * 2 + (dir == 0 ? s1 : 1 - s1);
        else { int c = s1 - 2; cn = b * 128 + (dir == 0 ? c : 127 - c); }
      }
#pragma unroll
      for (int m = 0; m < 4; ++m)
#pragma unroll
        for (int n = 0; n < 2; ++n) {
          int dk = wid * 64 + m * 16 + fq * 4, dv = n * 16 + fr;
          h16x4 hv;
#pragma unroll
          for (int j = 0; j < 4; ++j) hv[j] = (h16)S[m][n][j];
          *(h16x4*)(sS + dv * 264 + dk) = hv;
        }
      f32x4 Y[2][2]; acc_zero<2, 2>(Y);
      const h16* pa = sA + (wid * 32) * LDK;
      R2_QCOMMIT(q00, q10, q20, q30); R2_QCOMMIT2(q01, q11, q21, q31); __syncthreads();
      mma64<2, 2>(Y, sS, 264, pa, LDK, fr, fq);
      mma64<2, 2>(Y, sS + 64, 264, pa + 128 * LDK, LDK, fr, fq); __syncthreads();
      R2_QCOMMIT(q02, q12, q22, q32); R2_QCOMMIT2(q03, q13, q23, q33); __syncthreads();
      if (more) {
        int qo = (trow * 4) * 1024 + tkv * 8;
        asm volatile("" : "+v"(qo));
        const h16* qb = Q + (long)cn * 128 * 1024 + hh * 256 + qo;
        R2_QFETCH01(qb);
      }
      mma64<2, 2>(Y, sS + 128, 264, pa, LDK, fr, fq);
      mma64<2, 2>(Y, sS + 192, 264, pa + 128 * LDK, LDK, fr, fq); __syncthreads();
#pragma unroll
      for (int n = 0; n < 2; ++n) {
        int pp = wid * 32 + n * 16 + fr;
        float sc = ysc[pp];
        h16* d = Yd + (long)(cgk * 128 + pp) * 2048 + hh * 512 + sl * 32 + fq * 4;
#pragma unroll
        for (int m = 0; m < 2; ++m) {
          h16x4 o;
#pragma unroll
          for (int j = 0; j < 4; ++j) o[j] = (h16)(Y[m][n][j] * sc);
          *(h16x4*)(d + m * 16) = o;
        }
      }
#pragma unroll
      for (int m = 0; m < 4; ++m)
#pragma unroll
        for (int n = 0; n < 2; ++n) S[m][n] *= cdec;
      const h16* pk = sA + (wid * 64) * LDK;
      R2_KCOMMIT(ksh + tkv * 8, ka0, ka1, ka2, ka3, ka4, ka5, ka6, ka7); *(uint4*)vd = va; __syncthreads();
      if (more) {
        int ko = (trow * 8) * 128 + tkv * 8, vo = trow * 128 + tkv * 8;
        asm volatile("" : "+v"(ko), "+v"(vo));
        const h16* kbn = Kt + ((long)(cn * 4 + hh) * 256) * 128 + ko;
        const h16* vbn = Vt + ((long)(cn * 4 + hh) * 512 + sl * 32) * 128 + vo;
        R2_KFETCH(kbn, ka0, ka1, ka2, ka3, ka4, ka5, ka6, ka7); va = R2_LD(vbn);
      }
      mma64<4, 2>(S, pk, LDK, sB, LDK, fr, fq); __syncthreads();
      R2_KCOMMIT(ksh + 64 + tkv * 8, kb0, kb1, kb2, kb3, kb4, kb5, kb6, kb7); *(uint4*)vd = vb; __syncthreads();
      if (more) {
        int ko = (trow * 8) * 128 + tkv * 8 + 64, vo = trow * 128 + tkv * 8 + 64;
        asm volatile("" : "+v"(ko), "+v"(vo));
        const h16* kbn = Kt + ((long)(cn * 4 + hh) * 256) * 128 + ko;
        const h16* vbn = Vt + ((long)(cn * 4 + hh) * 512 + sl * 32) * 128 + vo;
        R2_KFETCH(kbn, kb0, kb1, kb2, kb3, kb4, kb5, kb6, kb7); vb = R2_LD(vbn);
        int qo = (trow * 4) * 1024 + tkv * 8;
        asm volatile("" : "+v"(qo));
        const h16* qb = Q + (long)cn * 128 * 1024 + hh * 256 + qo;
        R2_QFETCH23(qb);
      }
      mma64<4, 2>(S, pk, LDK, sB, LDK, fr, fq); __syncthreads();
    }
  }
}

__device__ __forceinline__ void phase_r3(const Params& p, int slot, char* smem, int tid) {
  h16* sA = (h16*)smem; h16* sB = sA + 128 * LDK;
  h16* sP = (h16*)smem;
  h16* sB2 = (h16*)(smem + 36864);
  const int wid = tid >> 6, lane = tid & 63, fr = lane & 15, fq = lane >> 4, wr = wid >> 1, wc = wid & 1;
  const h16* Q = (const h16*)(p.ws + OFF_Q); const h16* Kt = (const h16*)(p.ws + OFF_KT); const h16* Vt = (const h16*)(p.ws + OFF_VT);
  h16* Y1 = (h16*)(p.ws + OFF_Y1); const h16* Y2 = (const h16*)(p.ws + OFF_Y2);
  for (int job = blockIdx.x; job < NMT * 4; job += gridDim.x) {
    int cgk = job >> 2, hh = job & 3;
    float lgf = -fabsf(p.rdec[slot * 8 + hh]), lgb = -fabsf(p.rdec[slot * 8 + 4 + hh]);
    __syncthreads();
    {
      f32x4 acc[4][4]; acc_zero<4, 4>(acc);
      LdTR<128> ka; ka.init(Kt + (long)(cgk * 4 + hh) * 256 * 128, 128);
      LdRM<128, false> qb; qb.init(Q + (long)cgk * 128 * 1024 + hh * 256, 1024);
      gemm_stream<4, 4, 2, 2>(acc, ka, qb, 4, sA, sB, tid);
      int dbase = wc * 64 + fr - wr * 64 - fq * 4;
      asm volatile("" : "+v"(dbase));
#pragma unroll
      for (int m = 0; m < 4; ++m)
#pragma unroll
        for (int n = 0; n < 4; ++n) {
          int i = wc * 64 + n * 16 + fr; int j0 = wr * 64 + m * 16 + fq * 4;
          h16x4 hv;
#pragma unroll
          for (int jj = 0; jj < 4; ++jj) {
            int d = dbase + n * 16 - m * 16 - jj;
            float w = d == 0 ? 2.f : __expf((d > 0 ? lgf : lgb) * fabsf((float)d));
            hv[jj] = (h16)(acc[m][n][jj] * w);
          }
          *(h16x4*)(sP + i * 136 + j0) = hv;
        }
    }
    __syncthreads();
#pragma unroll 1
    for (int dvt = 0; dvt < 4; ++dvt) {
      f32x4 y[4][4]; acc_zero<4, 4>(y);
      LdRM<128, false> vb; vb.init(Vt + ((long)(cgk * 4 + hh) * 512 + dvt * 128) * 128, 128);
      LdRes pb; pb.base = sP; pb.ld = 136;
      gemm_stream<4, 4, 2, 2>(y, vb, pb, 2, sB2, sA, tid);
#pragma unroll
      for (int n = 0; n < 4; ++n) {
        long row = cgk * 128 + wc * 64 + n * 16 + fr;
        long base = row * 2048 + hh * 512 + dvt * 128 + wr * 64 + fq * 4;
#pragma unroll
        for (int m = 0; m < 4; ++m) {
          long idx = base + m * 16;
          h16x4 y1 = *(const h16x4*)(Y1 + idx), y2 = *(const h16x4*)(Y2 + idx), o;
#pragma unroll
          for (int j = 0; j < 4; ++j) o[j] = (h16)(y[m][n][j] + (float)y1[j] + (float)y2[j]);
          *(h16x4*)(Y1 + idx) = o;
        }
        asm volatile("" ::: "memory");
      }
    }
  }
}

__device__ __forceinline__ void phase_r5(const Params& p, char* smem, int tid) {
  h16* sA = (h16*)smem; h16* sB = sA + 128 * LDK;
  const int wid = tid >> 6, lane = tid & 63, fr = lane & 15, fq = lane >> 4, wr = wid >> 1, wc = wid & 1;
  const h16* H = (const h16*)(p.ws + OFF_H);
  const h16* W = (const h16*)(p.ws + OFF_WRI) + (long)4096 * 1024;
  h16* Y1 = (h16*)(p.ws + OFF_Y1);
  const float* gn = (const float*)(p.ws + OFF_GN);
  XcdWalk xw; xw.init();
  Ld2 la, lb;
  int u = xw.li;
  if (u < NMT * 2) {
    la.init(W + (long)(xw.xcd * 2 + (u & 1)) * 128 * 1024, 1024, tid); lb.init(H + (long)(u >> 1) * 128 * 1024, 1024, tid);
    g2_prefetch(la, lb);
  }
  for (; u < NMT * 2; u += xw.nloc) {
    int mt = u >> 1, nt = xw.xcd * 2 + (u & 1);
    f32x4 acc[4][4]; acc_zero<4, 4>(acc);
    gemm_stream2t<true>(acc, la, lb, 16, sA, tid);
    {
      int un = u + xw.nloc;
      if (un < NMT * 2) {
        la.init(W + (long)(xw.xcd * 2 + (un & 1)) * 128 * 1024, 1024, tid); lb.init(H + (long)(un >> 1) * 128 * 1024, 1024, tid);
        g2_prefetch(la, lb);
      }
    }
    int hh = nt >> 2;
#pragma unroll
    for (int n = 0; n < 4; ++n) {
      long row = mt * 128 + wc * 64 + n * 16 + fr;
      float mu = gn[(row * 4 + hh) * 2], rs = gn[(row * 4 + hh) * 2 + 1];
      h16* yp = Y1 + row * 2048 + nt * 128 + wr * 64 + fq * 4;
#pragma unroll
      for (int m = 0; m < 4; ++m) {
        h16x4 yv = *(const h16x4*)(yp + m * 16);
        h16x4 o;
#pragma unroll
        for (int j = 0; j < 4; ++j) {
          float yn = (float)(h16)(((float)yv[j] - mu) * rs);
          o[j] = (h16)(silu_f(acc[m][n][j]) * yn);
        }
        *(h16x4*)(yp + m * 16) = o;
      }
      asm volatile("" ::: "memory");
    }
  }
}

__device__ __forceinline__ void phase_final(const Params& p, int tid) {
  const int wid = tid >> 6, lane = tid & 63;
  for (int row0 = (blockIdx.x * 4 + wid) * 4; row0 < NLAT; row0 += gridDim.x * 16) {
    float4 v[4][4]; float rr[4];
#pragma unroll
    for (int r = 0; r < 4; ++r) {
      const float* xr = p.out + (long)(row0 + r) * 1024;
#pragma unroll
      for (int i = 0; i < 4; ++i) v[r][i] = ((const float4*)xr)[lane + 64 * i];
    }
#pragma unroll
    for (int r = 0; r < 4; ++r) {
      float a = 0.f;
#pragma unroll
      for (int i = 0; i < 4; ++i) a += v[r][i].x * v[r][i].x + v[r][i].y * v[r][i].y + v[r][i].z * v[r][i].z + v[r][i].w * v[r][i].w;
      rr[r] = rsqrtf(wave_sum(a, lane) * (1.f / 1024.f) + 1e-6f);
    }
#pragma unroll
    for (int i = 0; i < 4; ++i) {
      int c4 = lane + 64 * i;
      float4 gg = ((const float4*)p.final_g)[c4];
#pragma unroll
      for (int r = 0; r < 4; ++r) {
        float4 o; o.x = (v[r][i].x * rr[r]) * gg.x; o.y = (v[r][i].y * rr[r]) * gg.y; o.z = (v[r][i].z * rr[r]) * gg.z; o.w = (v[r][i].w * rr[r]) * gg.w;
        ((float4*)(p.out + (long)(row0 + r) * 1024))[c4] = o;
      }
    }
  }
}

#define XB_TMO      128
#define XB_XCNT(j)  (256  + 64 * (j))
#define XB_XSUB(j)  (1280 + 64 * (j))
#define XB_XGEN(j)  (2304 + 64 * (j))
#define XB_TOP      3328
#define XB_TOPGEN   3392
#define XCD_BAR_WORDS 3456
#define XB_SPIN_CAP (1u << 20)
#define LAS __attribute__((address_space(3)))
__device__ __forceinline__ unsigned xb_ld(unsigned* p) { return __hip_atomic_load(p, __ATOMIC_RELAXED, __HIP_MEMORY_SCOPE_AGENT); }
__device__ __forceinline__ unsigned xb_add(unsigned* p, unsigned v) { return __hip_atomic_fetch_add(p, v, __ATOMIC_RELAXED, __HIP_MEMORY_SCOPE_AGENT); }
__device__ __forceinline__ unsigned xb_xcc_id() { return (unsigned)__builtin_amdgcn_s_getreg((3 << 11) | 20) & 0xFu; }
#define XB_SPIN(cond, bar) do { unsigned _sp = 0; while (cond) { __builtin_amdgcn_s_sleep(1); \
    if ((++_sp & 255u) == 0u) { if (xb_ld(&(bar)[XB_TMO])) break; if (_sp > XB_SPIN_CAP) { atomicAdd(&(bar)[XB_TMO], 1u); break; } } } } while (0)
struct XcdBarrier { unsigned* bar; unsigned x; volatile LAS unsigned* st; };
__device__ __forceinline__ XcdBarrier xcd_barrier_post(unsigned* bar, volatile LAS unsigned* st, bool leader) {
  XcdBarrier b; b.bar = bar; b.x = xb_xcc_id(); b.st = st;
  if (leader) (void)xb_add(&bar[XB_XCNT(b.x)], 1u);
  return b;
}
__device__ __forceinline__ void xcd_barrier_complete(unsigned* bar, unsigned x, unsigned& nloc, unsigned& nx) {
  const unsigned G = gridDim.x * gridDim.y * gridDim.z;
  unsigned sum, cnt, mine, sp = 0u;
  for (;;) {
    sum = 0u; cnt = 0u; mine = 0u;
#pragma unroll
    for (unsigned j = 0; j < 16; ++j) { const unsigned c = xb_ld(&bar[XB_XCNT(j)]); sum += c; cnt += (c > 0u) ? 1u : 0u; mine = (j == x) ? c : mine; }
    if (sum == G) break;
    __builtin_amdgcn_s_sleep(1);
    if ((++sp & 255u) == 0u) { if (xb_ld(&bar[XB_TMO])) break; if (sp > XB_SPIN_CAP) { atomicAdd(&bar[XB_TMO], 1u); break; } }
  }
  nloc = mine > 0u ? mine : 1u; nx = cnt > 0u ? cnt : 1u;
}
__device__ __forceinline__ void xcd_barrier(const XcdBarrier& b, bool leader) {
  asm volatile("s_waitcnt vmcnt(0)" ::: "memory");
  __syncthreads();
  if (leader) {
    unsigned* bar = b.bar;
    __builtin_amdgcn_s_waitcnt(0);
    unsigned nloc = b.st[0], nx = b.st[1];
    if (nloc == 0u) { xcd_barrier_complete(bar, b.x, nloc, nx); b.st[0] = nloc; b.st[1] = nx; }
    const unsigned old = xb_add(&bar[XB_XSUB(b.x)], 1u);
    const unsigned gen = old / nloc;
    if (old + 1u == (gen + 1u) * nloc) {
      __builtin_amdgcn_fence(__ATOMIC_RELEASE, "agent");
      asm volatile("s_waitcnt vmcnt(0)" ::: "memory");
      const unsigned og = xb_add(&bar[XB_TOP], 1u);
      const unsigned tg = og / nx;
      if (og + 1u == (tg + 1u) * nx) xb_add(&bar[XB_TOPGEN], 1u);
      else XB_SPIN(xb_ld(&bar[XB_TOPGEN]) == tg, bar);
      __builtin_amdgcn_fence(__ATOMIC_ACQUIRE, "agent");
      xb_add(&bar[XB_XGEN(b.x)], 1u);
      asm volatile("s_waitcnt vmcnt(0)" ::: "memory");
    } else {
      XB_SPIN(xb_ld(&bar[XB_XGEN(b.x)]) == gen, bar);
      __builtin_amdgcn_fence(__ATOMIC_ACQUIRE, "agent");
      asm volatile("s_waitcnt vmcnt(0)" ::: "memory");
    }
  }
  __syncthreads();
}

enum { PH_NORM0, PH_G1A, PH_G2A, PH_NORM1, PH_S1, PH_S2, PH_FG, PH_R1, PH_R2, PH_R3, PH_R4, PH_R5, PH_R6, PH_NORM2, PH_G1B, PH_G2B };
#define NSTEPS 48

__device__ __forceinline__ void run_step(const Params& p, int step, char* smem, int tid) {
  if (step == 0) { phase_prep(p, smem, tid); return; }
  if (step == NSTEPS - 1) { phase_final(p, tid); return; }
  int s = step - 1, l, idx;
  if (s < 10) { l = 0; idx = s; } else if (s < 23) { l = 1; idx = s - 10; } else if (s < 33) { l = 2; idx = s - 23; } else { l = 3; idx = s - 33; }
  bool ret = (l & 1) == 1; int slot = l >> 1;
  int ph;
  if (idx < 4) ph = idx;
  else if (!ret) ph = (idx < 7) ? (PH_S1 + idx - 4) : (PH_NORM2 + idx - 7);
  else ph = (idx < 10) ? (PH_R1 + idx - 4) : (PH_NORM2 + idx - 10);
#ifdef SKIP_MASK
  if ((SKIP_MASK >> ph) & 1) return;
#endif
  const h16* act = (const h16*)(p.ws + OFF_ACT);
  if (ph == PH_NORM0 || ph == PH_NORM1 || ph == PH_NORM2 || ph == PH_R4) {
    int j = ph == PH_NORM0 ? 0 : (ph == PH_NORM2 ? 2 : 1);
    int extra = ph == PH_NORM0 ? 1 : (ph == PH_R4 ? 2 : 0);
    phase_norm(p, l, j, ph == PH_NORM0 && l == 0, extra, smem, tid);
  } else if (ph == PH_G1A || ph == PH_G1B) {
    phase_g1(p, ph == PH_G1A ? 0 : 1, smem, tid);
  } else if (ph == PH_G2A || ph == PH_G2B || ph == PH_FG || ph == PH_R6) {
    const h16* A; const h16* B; int K, gi; float coef; const float* bias = nullptr; bool first = false;
    if (ph == PH_G2A) { A = act; K = FF; B = (const h16*)(p.ws + OFF_WD0); gi = 2; coef = 0.5f; first = (l == 0); }
    else if (ph == PH_G2B) { A = act; K = FF; B = (const h16*)(p.ws + OFF_WD1); gi = 8; coef = 0.5f; }
    else if (ph == PH_FG) { A = (const h16*)(p.ws + OFF_FH); K = 2048; B = (const h16*)(p.ws + OFF_WF) + (long)slot * 1024 * 2048; gi = 5; coef = 1.f; bias = p.four_b + slot * 1024; }
    else { A = (const h16*)(p.ws + OFF_Y1); K = 2048; B = (const h16*)(p.ws + OFF_WRO); gi = 5; coef = 1.f; }
    phase_gemm_res(p, A, K, B, l, gi, coef, bias, first, smem, tid);
  } else if (ph == PH_S1) phase_s1(p, smem, tid);
  else if (ph == PH_S2) phase_s2(p, smem, tid);
  else if (ph == PH_R1) phase_r1(p, smem, tid);
  else if (ph == PH_R2) phase_r2(p, slot, smem, tid);
  else if (ph == PH_R3) phase_r3(p, slot, smem, tid);
  else if (ph == PH_R5) phase_r5(p, smem, tid);
}

__global__ void __launch_bounds__(256, 2) fwd_kernel(Params p, int first, int last, int coop) {
  __shared__ __attribute__((aligned(16))) char smem[SMEM_BYTES];
  __shared__ uint4 xb_words;
  const int wv = __builtin_amdgcn_readfirstlane((int)(threadIdx.x >> 6));
  {
    const int ln = (int)__builtin_amdgcn_mbcnt_hi(~0u, __builtin_amdgcn_mbcnt_lo(~0u, 0u));
    if (wv == 0 && ln == 0) xb_words = make_uint4(0u, 0u, 0u, 0u);
  }
  __syncthreads();
  XcdBarrier xb; xb.bar = (unsigned*)(p.ws + OFF_BAR); xb.x = 0; xb.st = (volatile LAS unsigned*)&xb_words;
  if (coop) {
    const int ln = (int)__builtin_amdgcn_mbcnt_hi(~0u, __builtin_amdgcn_mbcnt_lo(~0u, 0u));
    xb = xcd_barrier_post((unsigned*)(p.ws + OFF_BAR), (volatile LAS unsigned*)&xb_words, wv == 0 && ln == 0);
  }
  for (int step = first; step < last; ++step) {
    int tid;
    asm volatile("v_mbcnt_lo_u32_b32 %0, -1, 0\n\tv_mbcnt_hi_u32_b32 %0, -1, %0" : "=v"(tid));
    tid |= wv << 6;
    asm volatile("" : "+v"(tid));
    run_step(p, step, smem, tid);
    if (coop && step + 1 < last) {
      if (coop == 2) cg::this_grid().sync();
      else { const int ln = (int)__builtin_amdgcn_mbcnt_hi(~0u, __builtin_amdgcn_mbcnt_lo(~0u, 0u)); xcd_barrier(xb, wv == 0 && ln == 0); }
    }
  }
}

#ifndef MULTI_LAUNCH
#define MULTI_LAUNCH 0
#endif

extern "C" void kernel_launch(void* const* d_in, const int* in_sizes, int n_in, void* d_out, int out_size, void* d_ws, size_t ws_size,
                              hipStream_t stream) {
  if (ws_size < WS_NEED) { fprintf(stderr, "workspace too small: %zu < %zu\n", ws_size, (size_t)WS_NEED); return; }
  static int grid_blocks = 0;
  if (!grid_blocks) {
    int dev = 0, cus = 0, per_cu = 0;
    hipGetDevice(&dev);
    hipDeviceGetAttribute(&cus, hipDeviceAttributeMultiprocessorCount, dev);
    hipOccupancyMaxActiveBlocksPerMultiprocessor(&per_cu, fwd_kernel, 256, 0);
    if (per_cu > 2) per_cu = 2;
    if (per_cu < 1) per_cu = 1;
    grid_blocks = cus * per_cu;
  }
  Params p{};
  p.x = (const float*)d_in[0]; p.c = (const float*)d_in[1]; p.ctx = (const float*)d_in[2]; p.c_ctx = (const float*)d_in[3];
  p.ada_w = (const float*)d_in[4]; p.ada_b = (const float*)d_in[5]; p.norm_g = (const float*)d_in[6]; p.final_g = (const float*)d_in[7];
  p.wg = (const float*)d_in[8]; p.wu = (const float*)d_in[9]; p.wd = (const float*)d_in[10]; p.four_w = (const float*)d_in[11];
  p.four_b = (const float*)d_in[12]; p.rwi = (const float*)d_in[13]; p.rwo = (const float*)d_in[14]; p.rdec = (const float*)d_in[15];
  p.out = (float*)d_out; p.ws = (char*)d_ws;
#ifdef DIAG_MEMSET
  hipMemsetAsync(d_ws, 0, WS_NEED, stream);
#endif
#if MULTI_LAUNCH
  for (int s = 0; s < NSTEPS; ++s) fwd_kernel<<<grid_blocks, 256, 0, stream>>>(p, s, s + 1, 0);
#else
  hipMemsetAsync((char*)d_ws + OFF_BAR, 0, XCD_BAR_WORDS * 4, stream);
  int first = 0, last = NSTEPS, coop = 1;
  void* args[] = {&p, &first, &last, &coop};
  hipError_t e = hipLaunchCooperativeKernel((void*)fwd_kernel, dim3(grid_blocks), dim3(256), args, 0, stream);
  if (e != hipSuccess) fprintf(stderr, "cooperative launch failed: %s (grid %d)\n", hipGetErrorString(e), grid_blocks);
#endif
}
```

```cpp
#include <hip/hip_runtime.h>
#include <hip/hip_cooperative_groups.h>
#include <cstdio>
namespace cg = cooperative_groups;

typedef _Float16 h16;
typedef __attribute__((ext_vector_type(8))) _Float16 h16x8;
typedef __attribute__((ext_vector_type(4))) _Float16 h16x4;
typedef __attribute__((ext_vector_type(4))) float f32x4;

#define NLAT 32768
#define NCTX 512
#define MT 33280
#define NMT 260
#define FF 2816
#define LDK 72

struct Params {
  const float *x, *c, *ctx, *c_ctx, *ada_w, *ada_b, *norm_g, *final_g, *wg, *wu, *wd, *four_w, *four_b, *rwi, *rwo, *rdec;
  float* out;
  char* ws;
};

constexpr size_t AL(size_t x) { return (x + 255) & ~size_t(255); }
constexpr size_t OFF_MODS = 0;
constexpr size_t OFF_D1 = OFF_MODS + AL(4 * 3 * 9216 * 4);
constexpr size_t OFF_D2 = OFF_D1 + AL(256 * 128 * 2);
constexpr size_t OFF_D3 = OFF_D2 + AL(256 * 256 * 2);
constexpr size_t OFF_TW = OFF_D3 + AL(512 * 256 * 2);
constexpr size_t OFF_ROPE = OFF_TW + AL(128 * 128 * 2 * 4);
constexpr size_t OFF_CTXX = OFF_ROPE + AL(256 * 64 * 2 * 4);
constexpr size_t OFF_GN = OFF_CTXX + AL(512 * 1024 * 4);
constexpr size_t OFF_WF = OFF_GN + AL(33280 * 4 * 2 * 4);
constexpr size_t OFF_WGU0 = OFF_WF + AL(2 * 1024 * 2048 * 2);
constexpr size_t OFF_WD0 = OFF_WGU0 + AL(5632 * 1024 * 2);
constexpr size_t OFF_WGU1 = OFF_WD0 + AL(1024 * 2816 * 2);
constexpr size_t OFF_WD1 = OFF_WGU1 + AL(5632 * 1024 * 2);
constexpr size_t OFF_WRI = OFF_WD1 + AL(1024 * 2816 * 2);
constexpr size_t OFF_WRO = OFF_WRI + AL(6144 * 1024 * 2);
constexpr size_t OFF_R0 = OFF_WRO + AL(1024 * 2048 * 2);
constexpr size_t SZ_Y = (size_t)33280 * 2048 * 2;
constexpr size_t OFF_ACT = OFF_R0;
constexpr size_t OFF_AP = OFF_R0;
constexpr size_t OFF_FH = OFF_R0 + SZ_Y;
constexpr size_t OFF_Q = OFF_R0;
constexpr size_t OFF_KT = OFF_Q + (size_t)33280 * 1024 * 2;
constexpr size_t OFF_VT = OFF_KT + (size_t)33280 * 1024 * 2;
#ifdef DIAG_YSRC
constexpr size_t OFF_Y1 = OFF_R0;
#else
constexpr size_t OFF_Y1 = OFF_R0 + 2 * SZ_Y;
#endif
constexpr size_t OFF_Y2 = OFF_R0 + 3 * SZ_Y;
constexpr size_t OFF_H = OFF_Y2;
constexpr size_t OFF_BAR = OFF_R0 + 4 * SZ_Y;
constexpr size_t WS_NEED = OFF_BAR + 16384;

#define SMEM_BYTES 73728
#define ROPE_INLINE 1
#define DIAG_SWAP 0

__device__ __forceinline__ float silu_f(float v) { return v * __builtin_amdgcn_rcpf(1.f + __expf(-v)); }

#define LD_FOREACH(X) X(0, r0) X(1, r1) X(2, r2) X(3, r3) X(4, r4) X(5, r5) X(6, r6) X(7, r7)
template <int ROWS, bool SCALE>
struct LdRM {
  static constexpr int N = ROWS / 32;
  static constexpr bool kSwz = false;
  const h16* src; long ld; const float* ks; int k0;
  uint4 r0, r1, r2, r3, r4, r5, r6, r7;
  __device__ __forceinline__ void init(const h16* s, long l, const float* kscale = nullptr) { src = s; ld = l; ks = kscale; k0 = 0; }
  __device__ __forceinline__ void fetch(int kk0, int tid) {
    k0 = kk0;
#define X(i, R) if (i < N) { int v = tid + i * 256; int r = v >> 3, kv = v & 7; R = *(const uint4*)(src + (long)r * ld + kk0 + kv * 8); }
    LD_FOREACH(X)
#undef X
  }
  __device__ __forceinline__ void commit1(h16* s, int tid, int i, uint4 R) {
    int v = tid + i * 256; int r = v >> 3, kv = v & 7;
    if (SCALE) {
      h16x8 hv = __builtin_bit_cast(h16x8, R);
      h16x8 o;
#pragma unroll
      for (int e = 0; e < 8; ++e) o[e] = (h16)((float)hv[e] * ks[k0 + kv * 8 + e]);
      *(h16x8*)(s + r * LDK + kv * 8) = o;
    } else {
      *(uint4*)(s + r * LDK + kv * 8) = R;
    }
  }
  __device__ __forceinline__ void commit(h16* s, int tid) {
#define X(i, R) if (i < N) commit1(s, tid, i, R);
    LD_FOREACH(X)
#undef X
  }
  __device__ __forceinline__ const h16* slice(const h16* sdef, int) const { return sdef; }
  __device__ __forceinline__ int lds() const { return LDK; }
};

typedef __attribute__((ext_vector_type(2))) _Float16 h16x2;
template <int ROWS>
struct LdTR {
  static_assert(ROWS == 128, "LdTR is written for 128-row tiles");
  static constexpr bool kSwz = true;
  const h16* src; long ld;
  uint4 r0, r1, r2, r3;
  __device__ __forceinline__ void init(const h16* s, long l) { src = s; ld = l; }
  __device__ __forceinline__ void fetch(int kk0, int tid) {
    { int kp = tid >> 4, rv = tid & 15; const h16* p = src + (long)(kk0 + 2 * kp) * ld + rv * 8; r0 = *(const uint4*)p; r1 = *(const uint4*)(p + ld); }
    { int kp = (tid >> 4) + 16, rv = tid & 15; const h16* p = src + (long)(kk0 + 2 * kp) * ld + rv * 8; r2 = *(const uint4*)p; r3 = *(const uint4*)(p + ld); }
  }
  __device__ __forceinline__ void commit2(h16* s, int kp, int rv, uint4 A, uint4 B) {
    h16x8 ha = __builtin_bit_cast(h16x8, A), hb = __builtin_bit_cast(h16x8, B);
    const int k = 2 * kp;
    const int kpos = (((k >> 3) ^ (rv & 7)) << 3) | (k & 7);
#pragma unroll
    for (int e = 0; e < 8; ++e) { h16x2 pk = {ha[e], hb[e]}; *(h16x2*)(s + (rv * 8 + e) * LDK + kpos) = pk; }
  }
  __device__ __forceinline__ void commit(h16* s, int tid) {
    commit2(s, tid >> 4, tid & 15, r0, r1);
    commit2(s, (tid >> 4) + 16, tid & 15, r2, r3);
  }
  __device__ __forceinline__ const h16* slice(const h16* sdef, int) const { return sdef; }
  __device__ __forceinline__ int lds() const { return LDK; }
};

struct LdRes {
  static constexpr bool kSwz = false;
  const h16* base; int ld;
  __device__ __forceinline__ void fetch(int, int) {}
  __device__ __forceinline__ void commit(h16*, int) {}
  __device__ __forceinline__ const h16* slice(const h16*, int s) const { return base + s * 64; }
  __device__ __forceinline__ int lds() const { return ld; }
};

template <int WM, int WN, bool SWA = false, bool SWB = false>
__device__ __forceinline__ void mma64(f32x4 (&acc)[WM][WN], const h16* pa, int lda, const h16* pb, int ldb, int fr, int fq) {
  const int fx = fr >> 3;
#pragma unroll
  for (int ks = 0; ks < 2; ++ks) {
    h16x8 a[WM], b[WN];
#pragma unroll
    for (int m = 0; m < WM; ++m) a[m] = *(const h16x8*)(pa + (m * 16 + fr) * lda + (SWA ? (((ks * 4 + fq) ^ ((2 * m + fx) & 7)) * 8) : (ks * 32 + fq * 8)));
#pragma unroll
    for (int n = 0; n < WN; ++n) b[n] = *(const h16x8*)(pb + (n * 16 + fr) * ldb + (SWB ? (((ks * 4 + fq) ^ ((2 * n + fx) & 7)) * 8) : (ks * 32 + fq * 8)));

#pragma unroll
    for (int m = 0; m < WM; ++m)
#pragma unroll
      for (int n = 0; n < WN; ++n) acc[m][n] = __builtin_amdgcn_mfma_f32_16x16x32_f16(a[m], b[n], acc[m][n], 0, 0, 0);

  }
}

template <int WM, int WN, int WR, int WC, class LA, class LB>
__device__ __forceinline__ void gemm_stream(f32x4 (&acc)[WM][WN], LA& la, LB& lb, int nslices, h16* sA, h16* sB, int tid) {
  const int wid = tid >> 6, lane = tid & 63, fr = lane & 15, fq = lane >> 4;
  const int wr = wid / WC, wc = wid % WC;
  la.fetch(0, tid); lb.fetch(0, tid);
  for (int s = 0; s < nslices; ++s) {
    la.commit(sA, tid); lb.commit(sB, tid);
    __syncthreads();
    if (s + 1 < nslices) { la.fetch((s + 1) * 64, tid); lb.fetch((s + 1) * 64, tid); }
    const h16* pa = la.slice(sA, s) + (wr * 16 * WM) * la.lds();
    const h16* pb = lb.slice(sB, s) + (wc * 16 * WN) * lb.lds();
    mma64<WM, WN, LA::kSwz, LB::kSwz>(acc, pa, la.lds(), pb, lb.lds(), fr, fq);
    __syncthreads();
  }
}

struct Ld2 {
  const h16* tp; long rs;
  uint4 a0, a1, a2, a3, b0, b1, b2, b3;
  __device__ __forceinline__ void init(const h16* src, long ld, int tid) { tp = src + (long)(tid >> 3) * ld + (tid & 7) * 8; rs = 32 * ld; }
  __device__ __forceinline__ void fetchA(int k) {
    a0 = *(const uint4*)(tp + k); a1 = *(const uint4*)(tp + rs + k); a2 = *(const uint4*)(tp + 2 * rs + k); a3 = *(const uint4*)(tp + 3 * rs + k);
  }
  __device__ __forceinline__ void fetchB(int k) {
    b0 = *(const uint4*)(tp + k); b1 = *(const uint4*)(tp + rs + k); b2 = *(const uint4*)(tp + 2 * rs + k); b3 = *(const uint4*)(tp + 3 * rs + k);
  }
  __device__ __forceinline__ void commitA(h16* s, int tid) {
    h16* d = s + (tid >> 3) * 64 + (((tid & 7) ^ ((tid >> 4) & 7)) * 8);
    *(uint4*)d = a0; *(uint4*)(d + 32 * 64) = a1; *(uint4*)(d + 64 * 64) = a2; *(uint4*)(d + 96 * 64) = a3;
  }
  __device__ __forceinline__ void commitB(h16* s, int tid) {
    h16* d = s + (tid >> 3) * 64 + (((tid & 7) ^ ((tid >> 4) & 7)) * 8);
    *(uint4*)d = b0; *(uint4*)(d + 32 * 64) = b1; *(uint4*)(d + 64 * 64) = b2; *(uint4*)(d + 96 * 64) = b3;
  }
};

__device__ __forceinline__ void ldfr(h16x8 (&a)[4], h16x8 (&b)[4], const h16* pa, const h16* pb, int fr, int co) {
#pragma unroll
  for (int m = 0; m < 4; ++m) a[m] = *(const h16x8*)(pa + (m * 16 + fr) * 64 + co);
#pragma unroll
  for (int n = 0; n < 4; ++n) b[n] = *(const h16x8*)(pb + (n * 16 + fr) * 64 + co);
}
__device__ __forceinline__ void mfma16(f32x4 (&acc)[4][4], const h16x8 (&a)[4], const h16x8 (&b)[4]) {
  __builtin_amdgcn_s_setprio(1);
#pragma unroll
  for (int m = 0; m < 4; ++m)
#pragma unroll
    for (int n = 0; n < 4; ++n) acc[m][n] = __builtin_amdgcn_mfma_f32_16x16x32_f16(a[m], b[n], acc[m][n], 0, 0, 0);
  __builtin_amdgcn_s_setprio(0);
}

__device__ __forceinline__ void g2_prefetch(Ld2& la, Ld2& lb) { la.fetchA(0); lb.fetchA(0); }
template <bool PREFETCHED>
__device__ __forceinline__ void gemm_stream2t(f32x4 (&acc)[4][4], Ld2& la, Ld2& lb, int nslices, h16* sm, int tid) {
  h16* sA0 = sm; h16* sB0 = sA0 + 128 * 64; h16* sA1 = sB0 + 128 * 64; h16* sB1 = sA1 + 128 * 64;
  const int wid = tid >> 6, lane = tid & 63, fr = lane & 15, fq = lane >> 4;
  const int wr = wid >> 1, wc = wid & 1;
  const int c0 = (fq ^ ((fr >> 1) & 7)) * 8, c1 = c0 ^ 32;
  const h16* pa0 = sA0 + (wr * 64) * 64; const h16* pb0 = sB0 + (wc * 64) * 64;
  const h16* pa1 = sA1 + (wr * 64) * 64; const h16* pb1 = sB1 + (wc * 64) * 64;
  if (!PREFETCHED) g2_prefetch(la, lb);
  la.commitA(sA0, tid); lb.commitA(sB0, tid);
  la.fetchA(64); lb.fetchA(64);
  __syncthreads();
  h16x8 a0[4], b0[4], a1[4], b1[4];
  ldfr(a0, b0, pa0, pb0, fr, c0);
  for (int s = 0; s < nslices; s += 2) {
    ldfr(a1, b1, pa0, pb0, fr, c1);
    mfma16(acc, a0, b0);
    la.commitA(sA1, tid); lb.commitA(sB1, tid);
    if (s + 2 < nslices) { la.fetchA((s + 2) * 64); lb.fetchA((s + 2) * 64); }
    __syncthreads();
    ldfr(a0, b0, pa1, pb1, fr, c0);
    mfma16(acc, a1, b1);
    ldfr(a1, b1, pa1, pb1, fr, c1);
    mfma16(acc, a0, b0);
    if (s + 2 < nslices) {
      la.commitA(sA0, tid); lb.commitA(sB0, tid);
      la.fetchA((s + 3) * 64); lb.fetchA((s + 3) * 64);
    }
    __syncthreads();
    if (s + 2 < nslices) ldfr(a0, b0, pa0, pb0, fr, c0);
    mfma16(acc, a1, b1);
  }
  __syncthreads();
}
__device__ __forceinline__ void gemm_stream2(f32x4 (&acc)[4][4], Ld2& la, Ld2& lb, int nslices, h16* sm, int tid) {
  gemm_stream2t<false>(acc, la, lb, nslices, sm, tid);
}

struct XcdWalk {
  int xcd, li, nloc;
  __device__ __forceinline__ void init() { xcd = blockIdx.x & 7; li = blockIdx.x >> 3; nloc = (gridDim.x - xcd + 7) >> 3; }
};

template <int WM, int WN>
__device__ __forceinline__ void acc_zero(f32x4 (&acc)[WM][WN]) {
#pragma unroll
  for (int m = 0; m < WM; ++m)
#pragma unroll
    for (int n = 0; n < WN; ++n) acc[m][n] = f32x4{0.f, 0.f, 0.f, 0.f};
}

__device__ __forceinline__ int modset(int row) { return row < 16384 ? 0 : (row < NLAT ? 1 : 2); }
__device__ __forceinline__ const float* mod_ptr(const Params& p, int l, int s, int idx) {
  return (const float*)(p.ws + OFF_MODS) + ((long)(l * 3 + s) * 9216 + idx * 1024);
}
__device__ __forceinline__ const float* res_src(const Params& p, bool first, int row) {
  if (row < NLAT) return (first ? p.x : (const float*)p.out) + (long)row * 1024;
  return (first ? p.ctx : (const float*)(p.ws + OFF_CTXX)) + (long)(row - NLAT) * 1024;
}
__device__ __forceinline__ float* res_dst(const Params& p, int row) {
  if (row < NLAT) return p.out + (long)row * 1024;
  return (float*)(p.ws + OFF_CTXX) + (long)(row - NLAT) * 1024;
}
__device__ __forceinline__ float wave_sum(float v, int lane) {
#pragma unroll
  for (int o = 32; o > 0; o >>= 1) v += __int_as_float(__builtin_amdgcn_ds_bpermute((lane ^ o) << 2, __float_as_int(v)));
  return v;
}

__device__ __forceinline__ void phase_prep(const Params& p, char* smem, int tid) {
  const float PI2 = 6.283185307179586f;
  long gt = (long)blockIdx.x * 256 + tid, gs = (long)gridDim.x * 256;
  h16* D1 = (h16*)(p.ws + OFF_D1); h16* D2 = (h16*)(p.ws + OFF_D2); h16* D3 = (h16*)(p.ws + OFF_D3);
  float* TW = (float*)(p.ws + OFF_TW); float* RP = (float*)(p.ws + OFF_ROPE);
  const float is128 = 0.08838834764831845f;
  for (long i = gt; i < 256 * 128; i += gs) {
    int m = (int)(i >> 7), n1 = (int)(i & 127); int k1 = m >> 1, c = m & 1;
    float a = (float)((k1 * n1) & 127) * (1.f / 64.f);
    D1[i] = (h16)((c == 0 ? cospif(a) : -sinpif(a)) * is128);
  }
  for (long i = gt; i < 256 * 256; i += gs) {
    int m = (int)(i >> 8), kk = (int)(i & 255); int k2 = m >> 1, cp = m & 1, n2 = kk >> 1, c = kk & 1;
    float a = (float)((k2 * n2) & 127) * (1.f / 64.f);
    float C = cospif(a), S = sinpif(a);
    float v = (cp == 0) ? (c == 0 ? C : S) : (c == 0 ? -S : C);
    D2[i] = (h16)(v * is128);
  }
  for (long i = gt; i < 512 * 256; i += gs) {
    int m = (int)(i >> 8), n = (int)(i & 255); int k = m >> 1, c = m & 1;
    float a = (float)((k * n) & 255) * (1.f / 128.f);
    D3[i] = (h16)((c == 0 ? cospif(a) : -sinpif(a)) * 0.0625f);
  }
  for (long i = gt; i < 128 * 128; i += gs) {
    int k1 = (int)(i >> 7), n2 = (int)(i & 127);
    float a = (float)(k1 * n2) * (1.f / 8192.f);
    TW[2 * i] = cospif(a); TW[2 * i + 1] = sinpif(a);
  }
  float* sv = (float*)smem;
  float* red = sv + 3072;
  float* ctab = red + 768;
  float* stab = ctab + 256;
  for (int job = blockIdx.x; job < 576 + 1024; job += gridDim.x) {
    __syncthreads();
    if (job < 576) {
      int l = job / 144, colbase = (job % 144) * 64;
      for (int i = tid; i < 3072; i += 256) {
        int s = i >> 10, d = i & 1023;
        float cv = (s < 2) ? p.c[s * 1024 + d] : p.c_ctx[d];
        sv[i] = silu_f(cv);
      }
      __syncthreads();
      int col = tid & 63, dq = tid >> 6;
      float a0 = 0.f, a1 = 0.f, a2 = 0.f;
      const float* w = p.ada_w + ((long)l * 1024 + dq * 256) * 9216 + colbase + col;
#pragma unroll 32
      for (int d = 0; d < 256; ++d) {
        float wv = w[(long)d * 9216];
        int dd = dq * 256 + d;
        a0 += sv[dd] * wv; a1 += sv[1024 + dd] * wv; a2 += sv[2048 + dd] * wv;
      }
      red[(0 * 4 + dq) * 64 + col] = a0; red[(1 * 4 + dq) * 64 + col] = a1; red[(2 * 4 + dq) * 64 + col] = a2;
      __syncthreads();
      if (tid < 192) {
        int s = tid >> 6, cc = tid & 63;
        float v = red[(s * 4 + 0) * 64 + cc] + red[(s * 4 + 1) * 64 + cc] + red[(s * 4 + 2) * 64 + cc] + red[(s * 4 + 3) * 64 + cc];
        v += p.ada_b[l * 9216 + colbase + cc];
        ((float*)(p.ws + OFF_MODS))[(long)(l * 3 + s) * 9216 + colbase + cc] = v;
      }
    } else {
      int f = job - 576;
      int slot = f >> 9, r = f & 511, t = r >> 8, r2 = r & 255, g = r2 >> 6, r3 = r2 & 63, ct = r3 >> 2, ot = r3 & 3;
      ctab[tid] = cospif((float)tid * (1.f / 128.f)); stab[tid] = sinpif((float)tid * (1.f / 128.f));
      __syncthreads();
      const float* tab = t == 0 ? ctab : stab;
      int o = ot * 256 + tid;
      float acc[16];
#pragma unroll
      for (int ci = 0; ci < 16; ++ci) acc[ci] = 0.f;
      const float* W = p.four_w + ((long)slot * 1024 + g * 256) * 1024 + o;
#pragma unroll 32
      for (int m = 0; m < 256; ++m) {
        float wv = W[(long)m * 1024];
#pragma unroll
        for (int ci = 0; ci < 16; ++ci) acc[ci] += wv * tab[(m * (ct * 16 + ci)) & 255];
      }
      h16* dst = (h16*)(p.ws + OFF_WF) + ((long)slot * 1024 + o) * 2048 + t * 1024 + g * 256 + ct * 16;
      h16x8 o0, o1;
#pragma unroll
      for (int e = 0; e < 8; ++e) { o0[e] = (h16)(acc[e] * 0.0625f); o1[e] = (h16)(acc[8 + e] * 0.0625f); }
      *(h16x8*)dst = o0; *(h16x8*)(dst + 8) = o1;
    }
  }
}

__device__ __forceinline__ int conv_map(int mode, int n) {
  if (mode == 0) return n;
  if (mode == 1 || mode == 2) return (n >> 6) * 128 + ((n & 63) >> 4) * 32 + (mode == 2 ? 16 : 0) + (n & 15);
  if (n >= 2048) return n;
  int sec = n >> 10, hh = (n & 1023) >> 8, i = n & 255, half = i >> 7, ii = i & 127;
  return sec * 1024 + hh * 256 + (ii >> 6) * 128 + ((ii & 63) >> 4) * 32 + half * 16 + (ii & 15);
}
struct ConvJob { const float* src; long src_ld; h16* dst; long dst_ld; int k0, n0, mode; };
__device__ __forceinline__ ConvJob conv_decode(const Params& p, int l, int job) {
  ConvJob c;
  const int slot = l >> 1;
  if (job < 4224) {
    int seg = job / 704, r = job % 704; int f = seg / 3, kind = seg % 3;
    if (kind < 2) {
      c.src = (kind == 0 ? p.wg : p.wu) + (long)(l * 2 + f) * 1024 * FF; c.src_ld = FF;
      c.dst = (h16*)(p.ws + (f == 0 ? OFF_WGU0 : OFF_WGU1)); c.dst_ld = 1024;
      c.k0 = (r / 44) * 64; c.n0 = (r % 44) * 64; c.mode = kind == 0 ? 1 : 2;
    } else {
      c.src = p.wd + (long)(l * 2 + f) * FF * 1024; c.src_ld = 1024;
      c.dst = (h16*)(p.ws + (f == 0 ? OFF_WD0 : OFF_WD1)); c.dst_ld = FF;
      c.k0 = (r / 16) * 64; c.n0 = (r % 16) * 64; c.mode = 0;
    }
  } else {
    int r = job - 4224;
    if (r < 1536) {
      c.src = p.rwi + (long)slot * 1024 * 6144; c.src_ld = 6144; c.dst = (h16*)(p.ws + OFF_WRI); c.dst_ld = 1024;
      c.k0 = (r / 96) * 64; c.n0 = (r % 96) * 64; c.mode = 3;
    } else {
      r -= 1536;
      c.src = p.rwo + (long)slot * 2048 * 1024; c.src_ld = 1024; c.dst = (h16*)(p.ws + OFF_WRO); c.dst_ld = 2048;
      c.k0 = (r / 16) * 64; c.n0 = (r % 16) * 64; c.mode = 0;
    }
  }
  return c;
}
__device__ __forceinline__ void conv_load(const ConvJob& c, int tid, float4& v0, float4& v1, float4& v2, float4& v3) {
  const float* s0 = c.src + (long)(c.k0 + (tid >> 4)) * c.src_ld + c.n0 + (tid & 15) * 4;
  v0 = *(const float4*)s0; v1 = *(const float4*)(s0 + 16 * c.src_ld); v2 = *(const float4*)(s0 + 32 * c.src_ld); v3 = *(const float4*)(s0 + 48 * c.src_ld);
}
__device__ __forceinline__ void conv_store(const ConvJob& c, float* tile, int tid, float4 v0, float4 v1, float4 v2, float4 v3) {
  {
    float* t = tile + (tid >> 4) * 65 + (tid & 15) * 4;
    t[0] = v0.x; t[1] = v0.y; t[2] = v0.z; t[3] = v0.w;
    t[16 * 65] = v1.x; t[16 * 65 + 1] = v1.y; t[16 * 65 + 2] = v1.z; t[16 * 65 + 3] = v1.w;
    t[32 * 65] = v2.x; t[32 * 65 + 1] = v2.y; t[32 * 65 + 2] = v2.z; t[32 * 65 + 3] = v2.w;
    t[48 * 65] = v3.x; t[48 * 65 + 1] = v3.y; t[48 * 65 + 2] = v3.z; t[48 * 65 + 3] = v3.w;
  }
  __syncthreads();
  int nn = tid >> 2, kq = (tid & 3) * 16;
  h16x8 o0, o1;
#pragma unroll
  for (int e = 0; e < 8; ++e) { o0[e] = (h16)tile[(kq + e) * 65 + nn]; o1[e] = (h16)tile[(kq + 8 + e) * 65 + nn]; }
  int drow = conv_map(c.mode, c.n0 + nn);
  h16* d = c.dst + (long)drow * c.dst_ld + c.k0 + kq;
  *(h16x8*)d = o0; *(h16x8*)(d + 8) = o1;
  __syncthreads();
}

__device__ __forceinline__ void phase_norm(const Params& p, int l, int j, bool first, int extra, char* smem, int tid) {
  const int wid = tid >> 6, lane = tid & 63;
  h16* H = (h16*)(p.ws + OFF_H);
  const float* g = p.norm_g + (l * 3 + j) * 1024;
  for (int row0 = (blockIdx.x * 4 + wid) * 4; row0 < MT; row0 += gridDim.x * 16) {
    float4 v[4][4]; float ss[4];
#pragma unroll
    for (int r = 0; r < 4; ++r) {
      const float* xr = res_src(p, first, row0 + r);
#pragma unroll
      for (int i = 0; i < 4; ++i) v[r][i] = ((const float4*)xr)[lane + 64 * i];
    }
#pragma unroll
    for (int r = 0; r < 4; ++r) {
      float a = 0.f;
#pragma unroll
      for (int i = 0; i < 4; ++i) a += v[r][i].x * v[r][i].x + v[r][i].y * v[r][i].y + v[r][i].z * v[r][i].z + v[r][i].w * v[r][i].w;
      ss[r] = rsqrtf(wave_sum(a, lane) * (1.f / 1024.f) + 1e-6f);
    }
    int s = modset(row0);
    const float* sh = mod_ptr(p, l, s, 3 * j);
    const float* sc = mod_ptr(p, l, s, 3 * j + 1);
#pragma unroll
    for (int i = 0; i < 4; ++i) {
      int c4 = lane + 64 * i;
      float4 gg = ((const float4*)g)[c4], s4 = ((const float4*)sh)[c4], c4v = ((const float4*)sc)[c4];
#pragma unroll
      for (int r = 0; r < 4; ++r) {
        h16x4 o;
        o[0] = (h16)(((v[r][i].x * ss[r]) * gg.x) * (1.f + c4v.x) + s4.x);
        o[1] = (h16)(((v[r][i].y * ss[r]) * gg.y) * (1.f + c4v.y) + s4.y);
        o[2] = (h16)(((v[r][i].z * ss[r]) * gg.z) * (1.f + c4v.z) + s4.z);
        o[3] = (h16)(((v[r][i].w * ss[r]) * gg.w) * (1.f + c4v.w) + s4.w);
        *(h16x4*)(H + (long)(row0 + r) * 1024 + c4 * 4) = o;
      }
    }
  }
  if (extra == 1) {
    float* tile = (float*)smem;
    const bool ret = (l & 1) == 1;
    const int njobs = 6 * 704 + (ret ? 2048 : 0);
    int job = blockIdx.x;
    float4 c0, c1, c2, c3;
    ConvJob cj;
    if (job < njobs) { cj = conv_decode(p, l, job); conv_load(cj, tid, c0, c1, c2, c3); }
    while (job < njobs) {
      const int nj = job + gridDim.x;
      float4 d0 = c0, d1 = c1, d2 = c2, d3 = c3;
      ConvJob cc = cj;
      if (nj < njobs) { cj = conv_decode(p, l, nj); conv_load(cj, tid, c0, c1, c2, c3); }
      conv_store(cc, tile, tid, d0, d1, d2, d3);
      job = nj;
    }
  } else if (extra == 2) {
    const h16* Y1 = (const h16*)(p.ws + OFF_Y1);
    float* gn = (float*)(p.ws + OFF_GN);
    for (int w = blockIdx.x * 4 + wid; w < MT * 4; w += gridDim.x * 4) {
      int row = w >> 2, hh = w & 3;
      h16x8 hv = *(const h16x8*)(Y1 + (long)row * 2048 + hh * 512 + lane * 8);
      float f[8], s = 0.f;
#pragma unroll
      for (int e = 0; e < 8; ++e) { f[e] = (float)hv[e]; s += f[e]; }
      s = wave_sum(s, lane);
      float mu = s * (1.f / 512.f), q = 0.f;
#pragma unroll
      for (int e = 0; e < 8; ++e) { float d = f[e] - mu; q += d * d; }
      q = wave_sum(q, lane);
      if (lane == 0) { gn[w * 2] = mu; gn[w * 2 + 1] = rsqrtf(q * (1.f / 512.f) + 1e-6f); }
    }
  }
}

__device__ __forceinline__ void phase_g1(const Params& p, int f, char* smem, int tid) {
  h16* sA = (h16*)smem; h16* sB = sA + 128 * LDK;
  const int wid = tid >> 6, lane = tid & 63, fr = lane & 15, fq = lane >> 4, wr = wid >> 1, wc = wid & 1;
  const h16* H = (const h16*)(p.ws + OFF_H);
  const h16* W = (const h16*)(p.ws + (f == 0 ? OFF_WGU0 : OFF_WGU1));
  h16* act = (h16*)(p.ws + OFF_ACT);
  XcdWalk xw; xw.init();
  const int ng = xw.xcd & 3, mh = xw.xcd >> 2;
  Ld2 la, lb;
  int u = xw.li;
  if (u < 130 * 11) {
    la.init(W + (long)(ng * 11 + u % 11) * 128 * 1024, 1024, tid); lb.init(H + (long)(mh * 130 + u / 11) * 128 * 1024, 1024, tid);
    g2_prefetch(la, lb);
  }
  for (; u < 130 * 11; u += xw.nloc) {
    int mt = mh * 130 + u / 11, nt = ng * 11 + u % 11;
    f32x4 acc[4][4]; acc_zero<4, 4>(acc);
    gemm_stream2t<true>(acc, la, lb, 16, sA, tid);
    {
      int un = u + xw.nloc;
      if (un < 130 * 11) {
        la.init(W + (long)(ng * 11 + un % 11) * 128 * 1024, 1024, tid); lb.init(H + (long)(mh * 130 + un / 11) * 128 * 1024, 1024, tid);
        g2_prefetch(la, lb);
      }
    }
#pragma unroll
    for (int n = 0; n < 4; ++n) {
      long token = mt * 128 + wc * 64 + n * 16 + fr;
      h16* dst = act + token * FF + nt * 64 + fq * 4;
#pragma unroll
      for (int q = 0; q < 2; ++q) {
        h16x4 o;
#pragma unroll
        for (int j = 0; j < 4; ++j) o[j] = (h16)(silu_f(acc[2 * q][n][j]) * acc[2 * q + 1][n][j]);
        *(h16x4*)(dst + (wr * 2 + q) * 16) = o;
      }
    }
  }
}

__device__ __forceinline__ void phase_gemm_res(const Params& p, const h16* A, int K, const h16* B, int l, int gate_idx, float coef, const float* bias,
                               bool first, char* smem, int tid) {
  h16* sA = (h16*)smem;
  const int wid = tid >> 6, lane = tid & 63, fr = lane & 15, fq = lane >> 4, wr = wid >> 1, wc = wid & 1;
  XcdWalk xw; xw.init();
  const int ng = xw.xcd & 1, mq = xw.xcd >> 1;
  Ld2 la, lb;
  int u = xw.li;
  if (u < 256) {
    la.init(B + (long)(4 * ng + (u & 3)) * 128 * K, K, tid); lb.init(A + (long)(mq * 65 + (u >> 2)) * 128 * K, K, tid);
    g2_prefetch(la, lb);
  }
  for (; u < 256; u += xw.nloc) {
    int mt = mq * 65 + (u >> 2), nt = 4 * ng + (u & 3);
    f32x4 acc[4][4]; acc_zero<4, 4>(acc);
    gemm_stream2t<true>(acc, la, lb, K / 64, sA, tid);
    {
      int un = u + xw.nloc;
      if (un < 256) {
        la.init(B + (long)(4 * ng + (un & 3)) * 128 * K, K, tid); lb.init(A + (long)(mq * 65 + (un >> 2)) * 128 * K, K, tid);
        g2_prefetch(la, lb);
      }
    }
    int s = modset(mt * 128);
    const float* gate = mod_ptr(p, l, s, gate_idx);
    float4 gq[4], bq[4];
#pragma unroll
    for (int m = 0; m < 4; ++m) {
      int col = nt * 128 + wr * 64 + m * 16 + fq * 4;
      float4 g4 = *(const float4*)(gate + col);
      gq[m] = float4{coef * g4.x, coef * g4.y, coef * g4.z, coef * g4.w};
      bq[m] = bias ? *(const float4*)(bias + col) : float4{0.f, 0.f, 0.f, 0.f};
    }
#pragma unroll
    for (int n = 0; n < 4; ++n) {
      int row = mt * 128 + wc * 64 + n * 16 + fr;
      const float* xs = res_src(p, first, row);
      float* xd = res_dst(p, row);
#pragma unroll
      for (int m = 0; m < 4; ++m) {
        int col = nt * 128 + wr * 64 + m * 16 + fq * 4;
        float4 xv = *(const float4*)(xs + col);
        float4 o;
        o.x = xv.x + gq[m].x * (acc[m][n][0] + bq[m].x);
        o.y = xv.y + gq[m].y * (acc[m][n][1] + bq[m].y);
        o.z = xv.z + gq[m].z * (acc[m][n][2] + bq[m].z);
        o.w = xv.w + gq[m].w * (acc[m][n][3] + bq[m].w);
        *(float4*)(xd + col) = o;
      }
    }
  }
  {
    h16* qA = (h16*)smem; h16* qB = (h16*)(smem + 18432);
    const int tid2 = ((wr * 2 + wc) << 6) | (fq << 4) | fr;
    const int w4 = wr * 2 + wc;
    for (int v = xw.li; v < 16; v += xw.nloc) {
      int uu = 256 + (v >> 2), qr = v & 3;
      int mt = mq * 65 + (uu >> 2), nt = 4 * ng + (uu & 3);
      f32x4 acc[2][2]; acc_zero<2, 2>(acc);
      LdRM<128, false> lw; lw.init(B + (long)nt * 128 * K, K);
      LdRM<32, false> lx; lx.init(A + ((long)mt * 128 + qr * 32) * K, K);
      gemm_stream<2, 2, 4, 1>(acc, lw, lx, K / 64, qA, qB, tid2);
      int s = modset(mt * 128);
      const float* gate = mod_ptr(p, l, s, gate_idx);
#pragma unroll
      for (int n = 0; n < 2; ++n) {
        int row = mt * 128 + qr * 32 + n * 16 + fr;
        const float* xs = res_src(p, first, row);
        float* xd = res_dst(p, row);
#pragma unroll
        for (int m = 0; m < 2; ++m) {
          int col = nt * 128 + w4 * 32 + m * 16 + fq * 4;
          float4 xv = *(const float4*)(xs + col), g4 = *(const float4*)(gate + col);
          float4 b4 = bias ? *(const float4*)(bias + col) : float4{0.f, 0.f, 0.f, 0.f};
          float4 o;
          o.x = xv.x + coef * g4.x * (acc[m][n][0] + b4.x);
          o.y = xv.y + coef * g4.y * (acc[m][n][1] + b4.y);
          o.z = xv.z + coef * g4.z * (acc[m][n][2] + b4.z);
          o.w = xv.w + coef * g4.w * (acc[m][n][3] + b4.w);
          *(float4*)(xd + col) = o;
        }
      }
    }
  }
}

__device__ __forceinline__ void phase_s1(const Params& p, char* smem, int tid) {
  h16* sA = (h16*)smem; h16* sB = sA + 128 * LDK;
  const int wid = tid >> 6, lane = tid & 63, fr = lane & 15, fq = lane >> 4, wr = wid >> 1, wc = wid & 1;
  const h16* H = (const h16*)(p.ws + OFF_H);
  h16* AP = (h16*)(p.ws + OFF_AP); h16* FH = (h16*)(p.ws + OFF_FH);
  const float* TW = (const float*)(p.ws + OFF_TW);
  for (int job = blockIdx.x; job < 4096 + 64; job += gridDim.x) {
    f32x4 acc[4][4]; acc_zero<4, 4>(acc);
    if (job < 4096) {
      int mtile = job & 1, ct = (job >> 1) & 7, n2 = (job >> 4) & 127, b = job >> 11;
      LdRM<128, false> la; la.init((const h16*)(p.ws + OFF_D1) + mtile * 128 * 128, 128);
      LdTR<128> lb; lb.init(H + ((long)(b * 16384 + n2) * 1024 + ct * 128), 128 * 1024);
      gemm_stream<4, 4, 2, 2>(acc, la, lb, 2, sA, sB, tid);
#pragma unroll
      for (int m = 0; m < 4; ++m)
#pragma unroll
        for (int jp = 0; jp < 2; ++jp) {
          int row = mtile * 128 + wr * 64 + m * 16 + fq * 4 + 2 * jp; int k1 = row >> 1;
          float c = TW[(k1 * 128 + n2) * 2], s = TW[(k1 * 128 + n2) * 2 + 1];
          h16* d = AP + ((long)(b * 128 + k1) * 256 + 2 * n2) * 1024 + ct * 128 + wc * 64 + fr;
#pragma unroll
          for (int n = 0; n < 4; ++n) {
            float ar = acc[m][n][2 * jp], ai = acc[m][n][2 * jp + 1];
            d[n * 16] = (h16)(ar * c + ai * s);
            d[1024 + n * 16] = (h16)(ai * c - ar * s);
          }
        }
    } else {
      int jc = job - 4096; int mtile = jc & 3, ct = (jc >> 2) & 7, b = jc >> 5;
      LdRM<128, false> la; la.init((const h16*)(p.ws + OFF_D3) + mtile * 128 * 256, 256);
      LdTR<128> lb; lb.init(H + ((long)(NLAT + b * 256) * 1024 + ct * 128), 1024);
      gemm_stream<4, 4, 2, 2>(acc, la, lb, 4, sA, sB, tid);
#pragma unroll
      for (int m = 0; m < 4; ++m)
#pragma unroll
        for (int j = 0; j < 4; ++j) {
          int row = mtile * 128 + wr * 64 + m * 16 + fq * 4 + j; int k = row >> 1, c = row & 1;
          h16* d = FH + (long)(NLAT + b * 256 + k) * 2048 + c * 1024 + ct * 128 + wc * 64 + fr;
#pragma unroll
          for (int n = 0; n < 4; ++n) d[n * 16] = (h16)acc[m][n][j];
        }
    }
  }
}
__device__ __forceinline__ void phase_s2(const Params& p, char* smem, int tid) {
  h16* sA = (h16*)smem; h16* sB = sA + 128 * LDK;
  const int wid = tid >> 6, lane = tid & 63, fr = lane & 15, fq = lane >> 4, wr = wid >> 1, wc = wid & 1;
  const h16* AP = (const h16*)(p.ws + OFF_AP); h16* FH = (h16*)(p.ws + OFF_FH);
  for (int job = blockIdx.x; job < 4096; job += gridDim.x) {
    int mtile = job & 1, ct = (job >> 1) & 7, k1 = (job >> 4) & 127, b = job >> 11;
    f32x4 acc[4][4]; acc_zero<4, 4>(acc);
    LdRM<128, false> la; la.init((const h16*)(p.ws + OFF_D2) + mtile * 128 * 256, 256);
    LdTR<128> lb; lb.init(AP + ((long)(b * 128 + k1) * 256) * 1024 + ct * 128, 1024);
    gemm_stream<4, 4, 2, 2>(acc, la, lb, 4, sA, sB, tid);
#pragma unroll
    for (int m = 0; m < 4; ++m)
#pragma unroll
      for (int j = 0; j < 4; ++j) {
        int row = mtile * 128 + wr * 64 + m * 16 + fq * 4 + j; int k2 = row >> 1, c = row & 1;
        h16* d = FH + (long)(b * 16384 + k1 + 128 * k2) * 2048 + c * 1024 + ct * 128 + wc * 64 + fr;
#pragma unroll
        for (int n = 0; n < 4; ++n) d[n * 16] = (h16)acc[m][n][j];
      }
  }
}

__device__ __forceinline__ void phase_r1(const Params& p, char* smem, int tid) {
  h16* sA = (h16*)smem; h16* sB = sA + 128 * LDK;
  const int wid = tid >> 6, lane = tid & 63, fr = lane & 15, fq = lane >> 4, wr = wid >> 1, wc = wid & 1;
  const h16* H = (const h16*)(p.ws + OFF_H);
  const h16* W = (const h16*)(p.ws + OFF_WRI);
  h16* Q = (h16*)(p.ws + OFF_Q); h16* Kt = (h16*)(p.ws + OFF_KT); h16* Vt = (h16*)(p.ws + OFF_VT);
  const float* RP = (const float*)(p.ws + OFF_ROPE);
  XcdWalk xw; xw.init();
  Ld2 la, lb;
  int u = xw.li;
  if (u < NMT * 4) {
    la.init(H + (long)(u >> 2) * 128 * 1024, 1024, tid); lb.init(W + (long)(xw.xcd * 4 + (u & 3)) * 128 * 1024, 1024, tid);
    g2_prefetch(la, lb);
  }
  for (; u < NMT * 4; u += xw.nloc) {
    int mt = u >> 2, nt = xw.xcd * 4 + (u & 3);
    f32x4 acc[4][4]; acc_zero<4, 4>(acc);
    gemm_stream2t<true>(acc, la, lb, 16, sA, tid);
    {
      int un = u + xw.nloc;
      if (un < NMT * 4) {
        la.init(H + (long)(un >> 2) * 128 * 1024, 1024, tid); lb.init(W + (long)(xw.xcd * 4 + (un & 3)) * 128 * 1024, 1024, tid);
        g2_prefetch(la, lb);
      }
    }
    if (nt < 16) {
      bool isk = nt >= 8; int hh = (nt & 7) >> 1, tt = nt & 1;
      bool lat = mt < 256;
#pragma unroll
      for (int m = 0; m < 4; ++m)
#pragma unroll
        for (int q = 0; q < 2; ++q) {
          int i = tt * 64 + (wc * 2 + q) * 16 + fr;
          float o1[4], o2[4];
#pragma unroll
          for (int j = 0; j < 4; ++j) {
            int row = mt * 128 + wr * 64 + m * 16 + fq * 4 + j;
            float t1 = acc[m][2 * q][j], t2 = acc[m][2 * q + 1][j];
            if (lat) {
              int ntok = row & 16383;
              int pos = (i < 64) ? (ntok >> 6) : (ntok & 63);
              int fi = i & 63;
#ifdef ROPE_INLINE
              float ang = (float)pos * exp2f(-(float)fi * 0.20762050593046014f);
              float c = __cosf(ang), s = __sinf(ang);
#else
              float c = RP[(pos * 64 + fi) * 2], s = RP[(pos * 64 + fi) * 2 + 1];
#endif
              o1[j] = t1 * c - t2 * s; o2[j] = t2 * c + t1 * s;
            } else { o1[j] = t1; o2[j] = t2; }
          }
          if (!isk) {
#pragma unroll
            for (int j = 0; j < 4; ++j) {
              int row = mt * 128 + wr * 64 + m * 16 + fq * 4 + j;
              Q[(long)row * 1024 + hh * 256 + i] = (h16)o1[j];
              Q[(long)row * 1024 + hh * 256 + 128 + i] = (h16)o2[j];
            }
          } else {
            int tok = wr * 64 + m * 16 + fq * 4;
            h16x4 a, b2;
#pragma unroll
            for (int j = 0; j < 4; ++j) { a[j] = (h16)(o1[j] * 0.0625f); b2[j] = (h16)(o2[j] * 0.0625f); }
            *(h16x4*)(Kt + ((long)(mt * 4 + hh) * 256 + i) * 128 + tok) = a;
            *(h16x4*)(Kt + ((long)(mt * 4 + hh) * 256 + 128 + i) * 128 + tok) = b2;
          }
        }
    } else {
#pragma unroll
      for (int m = 0; m < 4; ++m)
#pragma unroll
        for (int n = 0; n < 4; ++n) {
          int v = (nt - 16) * 128 + wc * 64 + n * 16 + fr; int hh = v >> 9, dv = v & 511;
          int tok = wr * 64 + m * 16 + fq * 4;
          h16x4 a;
#pragma unroll
          for (int j = 0; j < 4; ++j) a[j] = (h16)acc[m][n][j];
          *(h16x4*)(Vt + ((long)(mt * 4 + hh) * 512 + dv) * 128 + tok) = a;
        }
    }
  }
}

__device__ __forceinline__ uint4 scale8(uint4 v, float4 s0, float4 s1) {
  h16x8 h = __builtin_bit_cast(h16x8, v); h16x8 o;
  o[0] = (h16)((float)h[0] * s0.x); o[1] = (h16)((float)h[1] * s0.y); o[2] = (h16)((float)h[2] * s0.z); o[3] = (h16)((float)h[3] * s0.w);
  o[4] = (h16)((float)h[4] * s1.x); o[5] = (h16)((float)h[5] * s1.y); o[6] = (h16)((float)h[6] * s1.z); o[7] = (h16)((float)h[7] * s1.w);
  return __builtin_bit_cast(uint4, o);
}
#define R2_LD(p) (*(const uint4*)(p))
#define R2_QFETCH(qb) do { \
    q00 = R2_LD(qb); q01 = R2_LD(qb + 64); q02 = R2_LD(qb + 128); q03 = R2_LD(qb + 192); \
    q10 = R2_LD(qb + 1024); q11 = R2_LD(qb + 1024 + 64); q12 = R2_LD(qb + 1024 + 128); q13 = R2_LD(qb + 1024 + 192); \
    q20 = R2_LD(qb + 2048); q21 = R2_LD(qb + 2048 + 64); q22 = R2_LD(qb + 2048 + 128); q23 = R2_LD(qb + 2048 + 192); \
    q30 = R2_LD(qb + 3072); q31 = R2_LD(qb + 3072 + 64); q32 = R2_LD(qb + 3072 + 128); q33 = R2_LD(qb + 3072 + 192); } while (0)
#define R2_QFETCH01(qb) do { q00 = R2_LD(qb); q01 = R2_LD(qb + 64); q10 = R2_LD(qb + 1024); q11 = R2_LD(qb + 1024 + 64); \
    q20 = R2_LD(qb + 2048); q21 = R2_LD(qb + 2048 + 64); q30 = R2_LD(qb + 3072); q31 = R2_LD(qb + 3072 + 64); } while (0)
#define R2_QFETCH23(qb) do { q02 = R2_LD(qb + 128); q03 = R2_LD(qb + 192); q12 = R2_LD(qb + 1024 + 128); q13 = R2_LD(qb + 1024 + 192); \
    q22 = R2_LD(qb + 2048 + 128); q23 = R2_LD(qb + 2048 + 192); q32 = R2_LD(qb + 3072 + 128); q33 = R2_LD(qb + 3072 + 192); } while (0)
#define R2_QCOMMIT(a, b, c, d) do { *(uint4*)(qd) = a; *(uint4*)(qd + LDK) = b; *(uint4*)(qd + 2 * LDK) = c; *(uint4*)(qd + 3 * LDK) = d; } while (0)
#define R2_KFETCH(kb, k0_, k1_, k2_, k3_, k4_, k5_, k6_, k7_) do { \
    k0_ = R2_LD(kb); k1_ = R2_LD(kb + 128); k2_ = R2_LD(kb + 256); k3_ = R2_LD(kb + 384); \
    k4_ = R2_LD(kb + 512); k5_ = R2_LD(kb + 640); k6_ = R2_LD(kb + 768); k7_ = R2_LD(kb + 896); } while (0)
__device__ __forceinline__ uint4 scale8h(uint4 v, h16x8 sc) {
  h16x8 h = __builtin_bit_cast(h16x8, v);
  h16x8 o = h * sc;
  return __builtin_bit_cast(uint4, o);
}
#define R2_KCOMMIT(sc, k0_, k1_, k2_, k3_, k4_, k5_, k6_, k7_) do { \
    const h16x8 s8_ = *(const h16x8*)(sc); \
    *(uint4*)(kd) = scale8h(k0_, s8_); *(uint4*)(kd + LDK) = scale8h(k1_, s8_); \
    *(uint4*)(kd + 2 * LDK) = scale8h(k2_, s8_); *(uint4*)(kd + 3 * LDK) = scale8h(k3_, s8_); \
    *(uint4*)(kd + 4 * LDK) = scale8h(k4_, s8_); *(uint4*)(kd + 5 * LDK) = scale8h(k5_, s8_); \
    *(uint4*)(kd + 6 * LDK) = scale8h(k6_, s8_); *(uint4*)(kd + 7 * LDK) = scale8h(k7_, s8_); } while (0)
#define R2_QCOMMIT2(a, b, c, d) do { *(uint4*)(qd + 128 * LDK) = a; *(uint4*)(qd + 129 * LDK) = b; *(uint4*)(qd + 130 * LDK) = c; *(uint4*)(qd + 131 * LDK) = d; } while (0)

__device__ __forceinline__ void phase_r2(const Params& p, int slot, char* smem, int tid) {
  h16* sA = (h16*)smem;
  h16* sB = (h16*)(smem + 36864);
  h16* sS = (h16*)(smem + 41472);
  float* ysc = (float*)(smem + 58368);
  h16* ksh = (h16*)(smem + 58880);
  const int wid = tid >> 6, lane = tid & 63, fr = lane & 15, fq = lane >> 4;
  const h16* Q = (const h16*)(p.ws + OFF_Q); const h16* Kt = (const h16*)(p.ws + OFF_KT); const h16* Vt = (const h16*)(p.ws + OFF_VT);
  const int trow = tid >> 3, tkv = tid & 7;
  h16* qd = sA + (trow * 4) * LDK + tkv * 8;
  h16* kd = sA + (trow * 8) * LDK + tkv * 8;
  h16* vd = sB + trow * LDK + tkv * 8;
  for (int job = blockIdx.x; job < 256; job += gridDim.x) {
    int chain = job >> 4, sl = job & 15;
    int b = chain >> 3, hh = (chain >> 1) & 3, dir = chain & 1;
    h16* Yd = (h16*)(p.ws + (dir == 0 ? OFF_Y1 : OFF_Y2));
    float lg = -fabsf(p.rdec[slot * 8 + dir * 4 + hh]);
    __syncthreads();
    if (wid < 2) {
      const int ti = wid * 64 + lane;
      float pp = (float)ti;
      ksh[ti] = (h16)(dir == 0 ? __expf(lg * (127.f - pp)) : __expf(lg * pp));
      ysc[ti] = dir == 0 ? __expf(lg * (pp + 1.f)) : __expf(lg * (128.f - pp));
    }
    float cdec = __expf(lg * 128.f);
    f32x4 S[4][2]; acc_zero<4, 2>(S);
    __syncthreads();
    uint4 q00, q01, q02, q03, q10, q11, q12, q13, q20, q21, q22, q23, q30, q31, q32, q33;
    uint4 ka0, ka1, ka2, ka3, ka4, ka5, ka6, ka7, kb0, kb1, kb2, kb3, kb4, kb5, kb6, kb7, va, vb;
    {
      int cg0 = 256 + b * 2 + (dir == 0 ? 0 : 1);
      const h16* kbp = Kt + ((long)(cg0 * 4 + hh) * 256) * 128 + (trow * 8) * 128 + tkv * 8;
      const h16* vbp = Vt + ((long)(cg0 * 4 + hh) * 512 + sl * 32) * 128 + trow * 128 + tkv * 8;
      R2_KFETCH(kbp, ka0, ka1, ka2, ka3, ka4, ka5, ka6, ka7); va = R2_LD(vbp);
      R2_KFETCH(kbp + 64, kb0, kb1, kb2, kb3, kb4, kb5, kb6, kb7); vb = R2_LD(vbp + 64);
      const h16* qb = Q + (long)cg0 * 128 * 1024 + hh * 256 + (trow * 4) * 1024 + tkv * 8;
      R2_QFETCH(qb);
    }
    for (int st = 0; st < 130; ++st) {
      int cgk, cn = 0;
      if (st < 2) cgk = 256 + b * 2 + (dir == 0 ? st : 1 - st);
      else { int c = st - 2; cgk = b * 128 + (dir == 0 ? c : 127 - c); }
      const bool more = st + 1 < 130;
      if (more) {
        int s1 = st + 1;
        if (s1 < 2) cn = 256 + b * 2 + (dir == 0 ? s1 : 1 - s1);
        else { int c = s1 - 2; cn = b * 128 + (dir == 0 ? c : 127 - c); }
      }
#pragma unroll
      for (int m = 0; m < 4; ++m)
#pragma unroll
        for (int n = 0; n < 2; ++n) {
          int dk = wid * 64 + m * 16 + fq * 4, dv = n * 16 + fr;
          h16x4 hv;
#pragma unroll
          for (int j = 0; j < 4; ++j) hv[j] = (h16)S[m][n][j];
          *(h16x4*)(sS + dv * 264 + dk) = hv;
        }
      f32x4 Y[2][2]; acc_zero<2, 2>(Y);
      const h16* pa = sA + (wid * 32) * LDK;
      R2_QCOMMIT(q00, q10, q20, q30); R2_QCOMMIT2(q01, q11, q21, q31); __syncthreads();
      mma64<2, 2>(Y, sS, 264, pa, LDK, fr, fq);
      mma64<2, 2>(Y, sS + 64, 264, pa + 128 * LDK, LDK, fr, fq); __syncthreads();
      R2_QCOMMIT(q02, q12, q22, q32); R2_QCOMMIT2(q03, q13, q23, q33); __syncthreads();
      if (more) {
        int qo = (trow * 4) * 1024 + tkv * 8;
        asm volatile("" : "+v"(qo));
        const h16* qb = Q + (long)cn * 128 * 1024 + hh * 256 + qo;
        R2_QFETCH01(qb);
      }
      mma64<2, 2>(Y, sS + 128, 264, pa, LDK, fr, fq);
      mma64<2, 2>(Y, sS + 192, 264, pa + 128 * LDK, LDK, fr, fq); __syncthreads();
#pragma unroll
      for (int n = 0; n < 2; ++n) {
        int pp = wid * 32 + n * 16 + fr;
        float sc = ysc[pp];
        h16* d = Yd + (long)(cgk * 128 + pp) * 2048 + hh * 512 + sl * 32 + fq * 4;
#pragma unroll
        for (int m = 0; m < 2; ++m) {
          h16x4 o;
#pragma unroll
          for (int j = 0; j < 4; ++j) o[j] = (h16)(Y[m][n][j] * sc);
          *(h16x4*)(d + m * 16) = o;
        }
      }
#pragma unroll
      for (int m = 0; m < 4; ++m)
#pragma unroll
        for (int n = 0; n < 2; ++n) S[m][n] *= cdec;
      const h16* pk = sA + (wid * 64) * LDK;
      R2_KCOMMIT(ksh + tkv * 8, ka0, ka1, ka2, ka3, ka4, ka5, ka6, ka7); *(uint4*)vd = va; __syncthreads();
      if (more) {
        int ko = (trow * 8) * 128 + tkv * 8, vo = trow * 128 + tkv * 8;
        asm volatile("" : "+v"(ko), "+v"(vo));
        const h16* kbn = Kt + ((long)(cn * 4 + hh) * 256) * 128 + ko;
        const h16* vbn = Vt + ((long)(cn * 4 + hh) * 512 + sl * 32) * 128 + vo;
        R2_KFETCH(kbn, ka0, ka1, ka2, ka3, ka4, ka5, ka6, ka7); va = R2_LD(vbn);
      }
      mma64<4, 2>(S, pk, LDK, sB, LDK, fr, fq); __syncthreads();
      R2_KCOMMIT(ksh + 64 + tkv * 8, kb0, kb1, kb2, kb3, kb4, kb5, kb6, kb7); *(uint4*)vd = vb; __syncthreads();
      if (more) {
        int ko = (trow * 8) * 128 + tkv * 8 + 64, vo = trow * 128 + tkv * 8 + 64;
        asm volatile("" : "+v"(ko), "+v"(vo));
        const h16* kbn = Kt + ((long)(cn * 4 + hh) * 256) * 128 + ko;
        const h16* vbn = Vt + ((long)(cn * 4 + hh) * 512 + sl * 32) * 128 + vo;
        R2_KFETCH(kbn, kb0, kb1, kb2, kb3, kb4, kb5, kb6, kb7); vb = R2_LD(vbn);
        int qo = (trow * 4) * 1024 + tkv * 8;
        asm volatile("" : "+v"(qo));
        const h16* qb = Q + (long)cn * 128 * 1024 + hh * 256 + qo;
        R2_QFETCH23(qb);
      }
      mma64<4, 2>(S, pk, LDK, sB, LDK, fr, fq); __syncthreads();
    }
  }
}

__device__ __forceinline__ void phase_r3(const Params& p, int slot, char* smem, int tid) {
  h16* sA = (h16*)smem; h16* sB = sA + 128 * LDK;
  h16* sP = (h16*)smem;
  h16* sB2 = (h16*)(smem + 36864);
  const int wid = tid >> 6, lane = tid & 63, fr = lane & 15, fq = lane >> 4, wr = wid >> 1, wc = wid & 1;
  const h16* Q = (const h16*)(p.ws + OFF_Q); const h16* Kt = (const h16*)(p.ws + OFF_KT); const h16* Vt = (const h16*)(p.ws + OFF_VT);
  h16* Y1 = (h16*)(p.ws + OFF_Y1); const h16* Y2 = (const h16*)(p.ws + OFF_Y2);
  for (int job = blockIdx.x; job < NMT * 4; job += gridDim.x) {
    int cgk = job >> 2, hh = job & 3;
    float lgf = -fabsf(p.rdec[slot * 8 + hh]), lgb = -fabsf(p.rdec[slot * 8 + 4 + hh]);
    __syncthreads();
    {
      f32x4 acc[4][4]; acc_zero<4, 4>(acc);
      LdTR<128> ka; ka.init(Kt + (long)(cgk * 4 + hh) * 256 * 128, 128);
      LdRM<128, false> qb; qb.init(Q + (long)cgk * 128 * 1024 + hh * 256, 1024);
      gemm_stream<4, 4, 2, 2>(acc, ka, qb, 4, sA, sB, tid);
      int dbase = wc * 64 + fr - wr * 64 - fq * 4;
      asm volatile("" : "+v"(dbase));
#pragma unroll
      for (int m = 0; m < 4; ++m)
#pragma unroll
        for (int n = 0; n < 4; ++n) {
          int i = wc * 64 + n * 16 + fr; int j0 = wr * 64 + m * 16 + fq * 4;
          h16x4 hv;
#pragma unroll
          for (int jj = 0; jj < 4; ++jj) {
            int d = dbase + n * 16 - m * 16 - jj;
            float w = d == 0 ? 2.f : __expf((d > 0 ? lgf : lgb) * fabsf((float)d));
            hv[jj] = (h16)(acc[m][n][jj] * w);
          }
          *(h16x4*)(sP + i * 136 + j0) = hv;
        }
    }
    __syncthreads();
#pragma unroll 1
    for (int dvt = 0; dvt < 4; ++dvt) {
      f32x4 y[4][4]; acc_zero<4, 4>(y);
      LdRM<128, false> vb; vb.init(Vt + ((long)(cgk * 4 + hh) * 512 + dvt * 128) * 128, 128);
      LdRes pb; pb.base = sP; pb.ld = 136;
      gemm_stream<4, 4, 2, 2>(y, vb, pb, 2, sB2, sA, tid);
#pragma unroll
      for (int n = 0; n < 4; ++n) {
        long row = cgk * 128 + wc * 64 + n * 16 + fr;
        long base = row * 2048 + hh * 512 + dvt * 128 + wr * 64 + fq * 4;
#pragma unroll
        for (int m = 0; m < 4; ++m) {
          long idx = base + m * 16;
          h16x4 y1 = *(const h16x4*)(Y1 + idx), y2 = *(const h16x4*)(Y2 + idx), o;
#pragma unroll
          for (int j = 0; j < 4; ++j) o[j] = (h16)(y[m][n][j] + (float)y1[j] + (float)y2[j]);
          *(h16x4*)(Y1 + idx) = o;
        }
        asm volatile("" ::: "memory");
      }
    }
  }
}

__device__ __forceinline__ void phase_r5(const Params& p, char* smem, int tid) {
  h16* sA = (h16*)smem; h16* sB = sA + 128 * LDK;
  const int wid = tid >> 6, lane = tid & 63, fr = lane & 15, fq = lane >> 4, wr = wid >> 1, wc = wid & 1;
  const h16* H = (const h16*)(p.ws + OFF_H);
  const h16* W = (const h16*)(p.ws + OFF_WRI) + (long)4096 * 1024;
  h16* Y1 = (h16*)(p.ws + OFF_Y1);
  const float* gn = (const float*)(p.ws + OFF_GN);
  XcdWalk xw; xw.init();
  Ld2 la, lb;
  int u = xw.li;
  if (u < NMT * 2) {
    la.init(W + (long)(xw.xcd * 2 + (u & 1)) * 128 * 1024, 1024, tid); lb.init(H + (long)(u >> 1) * 128 * 1024, 1024, tid);
    g2_prefetch(la, lb);
  }
  for (; u < NMT * 2; u += xw.nloc) {
    int mt = u >> 1, nt = xw.xcd * 2 + (u & 1);
    f32x4 acc[4][4]; acc_zero<4, 4>(acc);
    gemm_stream2t<true>(acc, la, lb, 16, sA, tid);
    {
      int un = u + xw.nloc;
      if (un < NMT * 2) {
        la.init(W + (long)(xw.xcd * 2 + (un & 1)) * 128 * 1024, 1024, tid); lb.init(H + (long)(un >> 1) * 128 * 1024, 1024, tid);
        g2_prefetch(la, lb);
      }
    }
    int hh = nt >> 2;
#pragma unroll
    for (int n = 0; n < 4; ++n) {
      long row = mt * 128 + wc * 64 + n * 16 + fr;
      float mu = gn[(row * 4 + hh) * 2], rs = gn[(row * 4 + hh) * 2 + 1];
      h16* yp = Y1 + row * 2048 + nt * 128 + wr * 64 + fq * 4;
#pragma unroll
      for (int m = 0; m < 4; ++m) {
        h16x4 yv = *(const h16x4*)(yp + m * 16);
        h16x4 o;
#pragma unroll
        for (int j = 0; j < 4; ++j) {
          float yn = (float)(h16)(((float)yv[j] - mu) * rs);
          o[j] = (h16)(silu_f(acc[m][n][j]) * yn);
        }
        *(h16x4*)(yp + m * 16) = o;
      }
      asm volatile("" ::: "memory");
    }
  }
}

__device__ __forceinline__ void phase_final(const Params& p, int tid) {
  const int wid = tid >> 6, lane = tid & 63;
  for (int row = blockIdx.x * 4 + wid; row < NLAT; row += gridDim.x * 4) {
    float* xr = p.out + (long)row * 1024;
    float4 v[4]; float ss = 0.f;
#pragma unroll
    for (int i = 0; i < 4; ++i) { v[i] = ((const float4*)xr)[lane + 64 * i]; ss += v[i].x * v[i].x + v[i].y * v[i].y + v[i].z * v[i].z + v[i].w * v[i].w; }
    ss = wave_sum(ss, lane);
    float r = rsqrtf(ss * (1.f / 1024.f) + 1e-6f);
#pragma unroll
    for (int i = 0; i < 4; ++i) {
      int c4 = lane + 64 * i;
      float4 gg = ((const float4*)p.final_g)[c4];
      float4 o; o.x = (v[i].x * r) * gg.x; o.y = (v[i].y * r) * gg.y; o.z = (v[i].z * r) * gg.z; o.w = (v[i].w * r) * gg.w;
      ((float4*)xr)[c4] = o;
    }
  }
}

#define XB_TMO      128
#define XB_XCNT(j)  (256  + 64 * (j))
#define XB_XSUB(j)  (1280 + 64 * (j))
#define XB_XGEN(j)  (2304 + 64 * (j))
#define XB_TOP      3328
#define XB_TOPGEN   3392
#define XCD_BAR_WORDS 3456
#define XB_SPIN_CAP (1u << 20)
#define LAS __attribute__((address_space(3)))
__device__ __forceinline__ unsigned xb_ld(unsigned* p) { return __hip_atomic_load(p, __ATOMIC_RELAXED, __HIP_MEMORY_SCOPE_AGENT); }
__device__ __forceinline__ unsigned xb_add(unsigned* p, unsigned v) { return __hip_atomic_fetch_add(p, v, __ATOMIC_RELAXED, __HIP_MEMORY_SCOPE_AGENT); }
__device__ __forceinline__ unsigned xb_xcc_id() { return (unsigned)__builtin_amdgcn_s_getreg((3 << 11) | 20) & 0xFu; }
#define XB_SPIN(cond, bar) do { unsigned _sp = 0; while (cond) { __builtin_amdgcn_s_sleep(1); \
    if ((++_sp & 255u) == 0u) { if (xb_ld(&(bar)[XB_TMO])) break; if (_sp > XB_SPIN_CAP) { atomicAdd(&(bar)[XB_TMO], 1u); break; } } } } while (0)
struct XcdBarrier { unsigned* bar; unsigned x; volatile LAS unsigned* st; };
__device__ __forceinline__ XcdBarrier xcd_barrier_post(unsigned* bar, volatile LAS unsigned* st, bool leader) {
  XcdBarrier b; b.bar = bar; b.x = xb_xcc_id(); b.st = st;
  if (leader) (void)xb_add(&bar[XB_XCNT(b.x)], 1u);
  return b;
}
__device__ __forceinline__ void xcd_barrier_complete(unsigned* bar, unsigned x, unsigned& nloc, unsigned& nx) {
  const unsigned G = gridDim.x * gridDim.y * gridDim.z;
  unsigned sum, cnt, mine, sp = 0u;
  for (;;) {
    sum = 0u; cnt = 0u; mine = 0u;
#pragma unroll
    for (unsigned j = 0; j < 16; ++j) { const unsigned c = xb_ld(&bar[XB_XCNT(j)]); sum += c; cnt += (c > 0u) ? 1u : 0u; mine = (j == x) ? c : mine; }
    if (sum == G) break;
    __builtin_amdgcn_s_sleep(1);
    if ((++sp & 255u) == 0u) { if (xb_ld(&bar[XB_TMO])) break; if (sp > XB_SPIN_CAP) { atomicAdd(&bar[XB_TMO], 1u); break; } }
  }
  nloc = mine > 0u ? mine : 1u; nx = cnt > 0u ? cnt : 1u;
}
__device__ __forceinline__ void xcd_barrier(const XcdBarrier& b, bool leader) {
  asm volatile("s_waitcnt vmcnt(0)" ::: "memory");
  __syncthreads();
  if (leader) {
    unsigned* bar = b.bar;
    __builtin_amdgcn_s_waitcnt(0);
    unsigned nloc = b.st[0], nx = b.st[1];
    if (nloc == 0u) { xcd_barrier_complete(bar, b.x, nloc, nx); b.st[0] = nloc; b.st[1] = nx; }
    const unsigned old = xb_add(&bar[XB_XSUB(b.x)], 1u);
    const unsigned gen = old / nloc;
    if (old + 1u == (gen + 1u) * nloc) {
      __builtin_amdgcn_fence(__ATOMIC_RELEASE, "agent");
      asm volatile("s_waitcnt vmcnt(0)" ::: "memory");
      const unsigned og = xb_add(&bar[XB_TOP], 1u);
      const unsigned tg = og / nx;
      if (og + 1u == (tg + 1u) * nx) xb_add(&bar[XB_TOPGEN], 1u);
      else XB_SPIN(xb_ld(&bar[XB_TOPGEN]) == tg, bar);
      __builtin_amdgcn_fence(__ATOMIC_ACQUIRE, "agent");
      xb_add(&bar[XB_XGEN(b.x)], 1u);
      asm volatile("s_waitcnt vmcnt(0)" ::: "memory");
    } else {
      XB_SPIN(xb_ld(&bar[XB_XGEN(b.x)]) == gen, bar);
      __builtin_amdgcn_fence(__ATOMIC_ACQUIRE, "agent");
      asm volatile("s_waitcnt vmcnt(0)" ::: "memory");
    }
  }
  __syncthreads();
}

enum { PH_NORM0, PH_G1A, PH_G2A, PH_NORM1, PH_S1, PH_S2, PH_FG, PH_R1, PH_R2, PH_R3, PH_R4, PH_R5, PH_R6, PH_NORM2, PH_G1B, PH_G2B };
#define NSTEPS 48

__device__ __forceinline__ void run_step(const Params& p, int step, char* smem, int tid) {
  if (step == 0) { phase_prep(p, smem, tid); return; }
  if (step == NSTEPS - 1) { phase_final(p, tid); return; }
  int s = step - 1, l, idx;
  if (s < 10) { l = 0; idx = s; } else if (s < 23) { l = 1; idx = s - 10; } else if (s < 33) { l = 2; idx = s - 23; } else { l = 3; idx = s - 33; }
  bool ret = (l & 1) == 1; int slot = l >> 1;
  int ph;
  if (idx < 4) ph = idx;
  else if (!ret) ph = (idx < 7) ? (PH_S1 + idx - 4) : (PH_NORM2 + idx - 7);
  else ph = (idx < 10) ? (PH_R1 + idx - 4) : (PH_NORM2 + idx - 10);
#ifdef SKIP_MASK
  if ((SKIP_MASK >> ph) & 1) return;
#endif
  const h16* act = (const h16*)(p.ws + OFF_ACT);
  if (ph == PH_NORM0 || ph == PH_NORM1 || ph == PH_NORM2 || ph == PH_R4) {
    int j = ph == PH_NORM0 ? 0 : (ph == PH_NORM2 ? 2 : 1);
    int extra = ph == PH_NORM0 ? 1 : (ph == PH_R4 ? 2 : 0);
    phase_norm(p, l, j, ph == PH_NORM0 && l == 0, extra, smem, tid);
  } else if (ph == PH_G1A || ph == PH_G1B) {
    phase_g1(p, ph == PH_G1A ? 0 : 1, smem, tid);
  } else if (ph == PH_G2A || ph == PH_G2B || ph == PH_FG || ph == PH_R6) {
    const h16* A; const h16* B; int K, gi; float coef; const float* bias = nullptr; bool first = false;
    if (ph == PH_G2A) { A = act; K = FF; B = (const h16*)(p.ws + OFF_WD0); gi = 2; coef = 0.5f; first = (l == 0); }
    else if (ph == PH_G2B) { A = act; K = FF; B = (const h16*)(p.ws + OFF_WD1); gi = 8; coef = 0.5f; }
    else if (ph == PH_FG) { A = (const h16*)(p.ws + OFF_FH); K = 2048; B = (const h16*)(p.ws + OFF_WF) + (long)slot * 1024 * 2048; gi = 5; coef = 1.f; bias = p.four_b + slot * 1024; }
    else { A = (const h16*)(p.ws + OFF_Y1); K = 2048; B = (const h16*)(p.ws + OFF_WRO); gi = 5; coef = 1.f; }
    phase_gemm_res(p, A, K, B, l, gi, coef, bias, first, smem, tid);
  } else if (ph == PH_S1) phase_s1(p, smem, tid);
  else if (ph == PH_S2) phase_s2(p, smem, tid);
  else if (ph == PH_R1) phase_r1(p, smem, tid);
  else if (ph == PH_R2) phase_r2(p, slot, smem, tid);
  else if (ph == PH_R3) phase_r3(p, slot, smem, tid);
  else if (ph == PH_R5) phase_r5(p, smem, tid);
}

__global__ void __launch_bounds__(256, 2) fwd_kernel(Params p, int first, int last, int coop) {
  __shared__ __attribute__((aligned(16))) char smem[SMEM_BYTES];
  __shared__ uint4 xb_words;
  const int wv = __builtin_amdgcn_readfirstlane((int)(threadIdx.x >> 6));
  {
    const int ln = (int)__builtin_amdgcn_mbcnt_hi(~0u, __builtin_amdgcn_mbcnt_lo(~0u, 0u));
    if (wv == 0 && ln == 0) xb_words = make_uint4(0u, 0u, 0u, 0u);
  }
  __syncthreads();
  XcdBarrier xb; xb.bar = (unsigned*)(p.ws + OFF_BAR); xb.x = 0; xb.st = (volatile LAS unsigned*)&xb_words;
  if (coop) {
    const int ln = (int)__builtin_amdgcn_mbcnt_hi(~0u, __builtin_amdgcn_mbcnt_lo(~0u, 0u));
    xb = xcd_barrier_post((unsigned*)(p.ws + OFF_BAR), (volatile LAS unsigned*)&xb_words, wv == 0 && ln == 0);
  }
  for (int step = first; step < last; ++step) {
    int tid;
    asm volatile("v_mbcnt_lo_u32_b32 %0, -1, 0\n\tv_mbcnt_hi_u32_b32 %0, -1, %0" : "=v"(tid));
    tid |= wv << 6;
    asm volatile("" : "+v"(tid));
    run_step(p, step, smem, tid);
    if (coop && step + 1 < last) {
      if (coop == 2) cg::this_grid().sync();
      else { const int ln = (int)__builtin_amdgcn_mbcnt_hi(~0u, __builtin_amdgcn_mbcnt_lo(~0u, 0u)); xcd_barrier(xb, wv == 0 && ln == 0); }
    }
  }
}

#ifndef MULTI_LAUNCH
#define MULTI_LAUNCH 0
#endif

extern "C" void kernel_launch(void* const* d_in, const int* in_sizes, int n_in, void* d_out, int out_size, void* d_ws, size_t ws_size,
                              hipStream_t stream) {
  if (ws_size < WS_NEED) { fprintf(stderr, "workspace too small: %zu < %zu\n", ws_size, (size_t)WS_NEED); return; }
  static int grid_blocks = 0;
  if (!grid_blocks) {
    int dev = 0, cus = 0, per_cu = 0;
    hipGetDevice(&dev);
    hipDeviceGetAttribute(&cus, hipDeviceAttributeMultiprocessorCount, dev);
    hipOccupancyMaxActiveBlocksPerMultiprocessor(&per_cu, fwd_kernel, 256, 0);
    if (per_cu > 2) per_cu = 2;
    if (per_cu < 1) per_cu = 1;
    grid_blocks = cus * per_cu;
  }
  Params p{};
  p.x = (const float*)d_in[0]; p.c = (const float*)d_in[1]; p.ctx = (const float*)d_in[2]; p.c_ctx = (const float*)d_in[3];
  p.ada_w = (const float*)d_in[4]; p.ada_b = (const float*)d_in[5]; p.norm_g = (const float*)d_in[6]; p.final_g = (const float*)d_in[7];
  p.wg = (const float*)d_in[8]; p.wu = (const float*)d_in[9]; p.wd = (const float*)d_in[10]; p.four_w = (const float*)d_in[11];
  p.four_b = (const float*)d_in[12]; p.rwi = (const float*)d_in[13]; p.rwo = (const float*)d_in[14]; p.rdec = (const float*)d_in[15];
  p.out = (float*)d_out; p.ws = (char*)d_ws;
#ifdef DIAG_MEMSET
  hipMemsetAsync(d_ws, 0, WS_NEED, stream);
#endif
#if MULTI_LAUNCH
  for (int s = 0; s < NSTEPS; ++s) fwd_kernel<<<grid_blocks, 256, 0, stream>>>(p, s, s + 1, 0);
#else
  hipMemsetAsync((char*)d_ws + OFF_BAR, 0, XCD_BAR_WORDS * 4, stream);
  int first = 0, last = NSTEPS, coop = 1;
  void* args[] = {&p, &first, &last, &coop};
  hipError_t e = hipLaunchCooperativeKernel((void*)fwd_kernel, dim3(grid_blocks), dim3(256), args, 0, stream);
  if (e != hipSuccess) fprintf(stderr, "cooperative launch failed: %s (grid %d)\n", hipGetErrorString(e), grid_blocks);
#endif
}
```
